# Optimizing an MI355X kernel written in HIP

```python
import jax, jax.numpy as jnp
from jax import lax
import numpy as np

D_MODEL = 2048
BATCH = 2
SEQ = 16384
DEPTH = 2
DEC_BATCH = 16
DEC_SEQ = 32
PAST_LEN = 1024

CHUNK = 64
N_MIXERS = 2
N_FOX = (DEPTH + 1) // 2
N_SWA = DEPTH // 2
FOX_HEADS = 16
FOX_HD = D_MODEL // FOX_HEADS
FOX_QBLOCK = 128
FORGET_BIAS_INIT = 3.0
SWA_HEADS = 32
SWA_KV_HEADS = 4
SWA_GROUP = SWA_HEADS // SWA_KV_HEADS
SWA_HD = D_MODEL // SWA_HEADS
SWA_WINDOW = 128
SWA_WINDOW_CHUNKS = SWA_WINDOW // CHUNK
ROPE_THETA = 500000.0
ROPE_DIMS = SWA_HD // 4
D_FF = 4 * D_MODEL
RMS_EPS = 1e-6

kernel_name = "fox_swa_sink_hybrid_stream_step"


def rms_norm(x, g):
    x32 = x.astype(jnp.float32)
    y = x32 * lax.rsqrt(jnp.mean(x32 * x32, axis=-1, keepdims=True) + RMS_EPS)
    return y.astype(x.dtype) * g


def ada_params(c, w_mod, b_mod):
    m = jax.nn.silu(c) @ w_mod + b_mod
    return jnp.split(m[:, None, :], 6, axis=-1)


def modulate(h, shift, scale):
    return h * (1 + scale) + shift


def sq_relu_mlp(h, w_up, w_down):
    a = jax.nn.relu(h @ w_up)
    return (a * a) @ w_down


def partial_rope(x, pos):
    half = ROPE_DIMS // 2
    inv_freq = ROPE_THETA ** (-jnp.arange(half, dtype=jnp.float32) * 2.0 / ROPE_DIMS)
    ang = pos.astype(jnp.float32)[:, None] * inv_freq[None, :]
    cos = jnp.cos(ang)[:, None, :]
    sin = jnp.sin(ang)[:, None, :]
    x32 = x.astype(jnp.float32)
    x1 = x32[..., :half]
    x2 = x32[..., half:ROPE_DIMS]
    rot = jnp.concatenate([x1 * cos - x2 * sin, x2 * cos + x1 * sin], axis=-1).astype(x.dtype)
    return jnp.concatenate([rot, x[..., ROPE_DIMS:]], axis=-1)


def fox_project(h, w_in, b_f):
    b, t, _ = h.shape
    d = D_MODEL
    proj = h @ w_in
    q = proj[..., :d].reshape(b, t, FOX_HEADS, FOX_HD)
    k = proj[..., d:2 * d].reshape(b, t, FOX_HEADS, FOX_HD)
    v = proj[..., 2 * d:3 * d].reshape(b, t, FOX_HEADS, FOX_HD)
    logf = jax.nn.log_sigmoid((proj[..., 3 * d:] + b_f).astype(jnp.float32))
    return q, k, v, logf


def fox_attend(q, k, v, cq, ck, q_pos, k_pos):
    s = jnp.einsum('bqhd,bkhd->bhqk', q, k).astype(jnp.float32) * (FOX_HD ** -0.5)
    s = s + jnp.swapaxes(cq, 1, 2)[..., :, None] - jnp.swapaxes(ck, 1, 2)[..., None, :]
    s = jnp.where(k_pos[None, :] <= q_pos[:, None], s, -jnp.inf)
    p = jax.nn.softmax(s, axis=-1)
    return jnp.einsum('bhqk,bkhd->bqhd', p.astype(v.dtype), v)


def fox_prompt(q, k, v, logf):
    b, s, h, d = q.shape
    c = jnp.cumsum(logf, axis=1)
    pos = jnp.arange(s)
    nb = s // FOX_QBLOCK
    qb = q.reshape(b, nb, FOX_QBLOCK, h, d).swapaxes(0, 1)
    cb = c.reshape(b, nb, FOX_QBLOCK, h).swapaxes(0, 1)
    pb = pos.reshape(nb, FOX_QBLOCK)
    out = lax.map(lambda a: fox_attend(a[0], k, v, a[1], c, a[2], pos), (qb, cb, pb))
    return out.swapaxes(0, 1).reshape(b, s, h * d)


def fox_sample(q, k, v, logf, ck_cache, cv_cache, clogf_cache):
    b, t, h, d = q.shape
    p_len = ck_cache.shape[1]
    k_all = jnp.concatenate([ck_cache.astype(k.dtype), k], axis=1)
    v_all = jnp.concatenate([cv_cache.astype(v.dtype), v], axis=1)
    c_all = jnp.cumsum(jnp.concatenate([clogf_cache.astype(jnp.float32), logf], axis=1), axis=1)
    k_pos = jnp.arange(p_len + t)
    q_pos = p_len + jnp.arange(t)
    out = fox_attend(q, k_all, v_all, c_all[:, p_len:], c_all, q_pos, k_pos)
    return out.reshape(b, t, h * d)


def swa_project(h, w_in, pos):
    b, t, _ = h.shape
    qd = SWA_HEADS * SWA_HD
    kvd = SWA_KV_HEADS * SWA_HD
    proj = h @ w_in
    q = partial_rope(proj[..., :qd].reshape(b, t, SWA_HEADS, SWA_HD), pos)
    k = partial_rope(proj[..., qd:qd + kvd].reshape(b, t, SWA_KV_HEADS, SWA_HD), pos)
    v = proj[..., qd + kvd:].reshape(b, t, SWA_KV_HEADS, SWA_HD)
    return q, k, v


def sink_attend(q, k, v, mask, sinks):
    s = jnp.einsum('bnqhgd,bnshd->bnhgqs', q, k).astype(jnp.float32) * (SWA_HD ** -0.5)
    s = jnp.where(mask[None, :, None, None], s, -jnp.inf)
    sink = sinks.astype(jnp.float32)[None, None, :, :, None, None]
    m = jnp.maximum(jnp.max(s, axis=-1, keepdims=True), sink)
    p = jnp.exp(s - m)
    p = p / (jnp.sum(p, axis=-1, keepdims=True) + jnp.exp(sink - m))
    return jnp.einsum('bnhgqs,bnshd->bnqhgd', p.astype(v.dtype), v)


def swa_prompt(q, k, v, sinks):
    b, s, _, _ = q.shape
    nc = s // CHUNK
    w = SWA_WINDOW_CHUNKS
    qc = q.reshape(b, nc, CHUNK, SWA_KV_HEADS, SWA_GROUP, SWA_HD)
    pad = jnp.zeros((b, w, CHUNK, SWA_KV_HEADS, SWA_HD), k.dtype)
    kp = jnp.concatenate([pad, k.reshape(b, nc, CHUNK, SWA_KV_HEADS, SWA_HD)], axis=1)
    vp = jnp.concatenate([pad.astype(v.dtype), v.reshape(b, nc, CHUNK, SWA_KV_HEADS, SWA_HD)], axis=1)
    kb = jnp.concatenate([kp[:, j:j + nc] for j in range(w + 1)], axis=2)
    vb = jnp.concatenate([vp[:, j:j + nc] for j in range(w + 1)], axis=2)
    offs = jnp.repeat(jnp.arange(w + 1), CHUNK)
    kchunk = jnp.arange(nc)[:, None] - w + offs[None, :]
    mask = (kchunk >= 0)[:, None, :]
    out = sink_attend(qc, kb, vb, mask, sinks.reshape(SWA_KV_HEADS, SWA_GROUP))
    return out.reshape(b, s, D_MODEL)


def swa_sample(q, k, v, sinks, ck_cache, cv_cache, past_len):
    b, t, _, _ = q.shape
    buf = ck_cache.shape[1]
    k_all = jnp.concatenate([ck_cache.astype(k.dtype), k], axis=1)
    v_all = jnp.concatenate([cv_cache.astype(v.dtype), v], axis=1)
    q_pos = past_len + jnp.arange(t)
    k_pos = jnp.concatenate([past_len - buf + jnp.arange(buf), q_pos])
    qch = q_pos // CHUNK
    kch = k_pos // CHUNK
    mask = (kch[None, :] <= qch[:, None]) & (kch[None, :] >= qch[:, None] - SWA_WINDOW_CHUNKS)
    out = sink_attend(q.reshape(b, 1, t, SWA_KV_HEADS, SWA_GROUP, SWA_HD), k_all[:, None], v_all[:, None],
                      mask[None], sinks.reshape(SWA_KV_HEADS, SWA_GROUP))
    return out.reshape(b, t, D_MODEL), k_all[:, -buf:], v_all[:, -buf:]


def setup_inputs(seed: int = 0) -> dict:
    key = jax.random.key(seed)
    ks = jax.random.split(key, 24)
    n = jax.random.normal
    d = D_MODEL
    wbuf = min(SWA_WINDOW, PAST_LEN)
    fox_in = 3 * d + FOX_HEADS
    swa_in = SWA_HEADS * SWA_HD + 2 * SWA_KV_HEADS * SWA_HD
    return {
        "x_prompt": n(ks[0], (BATCH, SEQ, d), jnp.float32),
        "x_sample": n(ks[1], (DEC_BATCH, DEC_SEQ, d), jnp.float32),
        "c_prompt": n(ks[2], (BATCH, d), jnp.float32),
        "c_sample": n(ks[3], (DEC_BATCH, d), jnp.float32),
        "cache_fox_k": n(ks[4], (N_FOX, DEC_BATCH, PAST_LEN, FOX_HEADS, FOX_HD), jnp.float32),
        "cache_fox_v": n(ks[5], (N_FOX, DEC_BATCH, PAST_LEN, FOX_HEADS, FOX_HD), jnp.float32),
        "cache_fox_logf": jax.nn.log_sigmoid(FORGET_BIAS_INIT + n(ks[6], (N_FOX, DEC_BATCH, PAST_LEN, FOX_HEADS), jnp.float32)),
        "cache_swa_k": n(ks[7], (N_SWA, DEC_BATCH, wbuf, SWA_KV_HEADS, SWA_HD), jnp.float32),
        "cache_swa_v": n(ks[8], (N_SWA, DEC_BATCH, wbuf, SWA_KV_HEADS, SWA_HD), jnp.float32),
        "ada_w": n(ks[9], (DEPTH, d, 6 * d), jnp.float32) * (0.5 * d ** -0.5),
        "ada_b": n(ks[10], (DEPTH, 6 * d), jnp.float32) * 0.02,
        "norm_mix_g": 1.0 + 0.05 * n(ks[11], (DEPTH, d), jnp.float32),
        "norm_ffn_g": 1.0 + 0.05 * n(ks[12], (DEPTH, d), jnp.float32),
        "fox_w_in": n(ks[13], (N_FOX, d, fox_in), jnp.float32) * d ** -0.5,
        "fox_b_f": FORGET_BIAS_INIT + 0.1 * n(ks[14], (N_FOX, FOX_HEADS), jnp.float32),
        "fox_w_out": n(ks[15], (N_FOX, d, d), jnp.float32) * d ** -0.5,
        "swa_w_in": n(ks[16], (N_SWA, d, swa_in), jnp.float32) * d ** -0.5,
        "swa_sinks": 0.5 * n(ks[17], (N_SWA, SWA_HEADS), jnp.float32),
        "swa_w_out": n(ks[18], (N_SWA, d, d), jnp.float32) * d ** -0.5,
        "ffn_w_up": n(ks[19], (DEPTH, d, D_FF), jnp.float32) * d ** -0.5,
        "ffn_w_down": n(ks[20], (DEPTH, D_FF, d), jnp.float32) * D_FF ** -0.5,
        "final_g": 1.0 + 0.05 * n(ks[21], (d,), jnp.float32),
    }


def reference(x_prompt, x_sample, c_prompt, c_sample, cache_fox_k, cache_fox_v, cache_fox_logf,
              cache_swa_k, cache_swa_v, ada_w, ada_b, norm_mix_g, norm_ffn_g, fox_w_in, fox_b_f,
              fox_w_out, swa_w_in, swa_sinks, swa_w_out, ffn_w_up, ffn_w_down, final_g):
    past_len = cache_fox_k.shape[2]
    pos_p = jnp.arange(x_prompt.shape[1])
    pos_s = past_len + jnp.arange(x_sample.shape[1])
    xp, xs = x_prompt, x_sample
    fkp, fvp, flp, fks, fvs, fls = [], [], [], [], [], []
    skp, svp, sks, svs = [], [], [], []
    for i in range(DEPTH):
        mp = ada_params(c_prompt, ada_w[i], ada_b[i])
        ms = ada_params(c_sample, ada_w[i], ada_b[i])
        hp = modulate(rms_norm(xp, norm_mix_g[i]), mp[0], mp[1])
        hs = modulate(rms_norm(xs, norm_mix_g[i]), ms[0], ms[1])
        j = i // N_MIXERS
        if i % N_MIXERS == 0:
            q, k, v, lf = fox_project(hp, fox_w_in[j], fox_b_f[j])
            op = fox_prompt(q, k, v, lf) @ fox_w_out[j]
            fkp.append(k); fvp.append(v); flp.append(lf)
            q, k, v, lf = fox_project(hs, fox_w_in[j], fox_b_f[j])
            os_ = fox_sample(q, k, v, lf, cache_fox_k[j], cache_fox_v[j], cache_fox_logf[j]) @ fox_w_out[j]
            fks.append(k); fvs.append(v); fls.append(lf)
        else:
            buf = cache_swa_k.shape[2]
            q, k, v = swa_project(hp, swa_w_in[j], pos_p)
            op = swa_prompt(q, k, v, swa_sinks[j]) @ swa_w_out[j]
            skp.append(k[:, -buf:]); svp.append(v[:, -buf:])
            q, k, v = swa_project(hs, swa_w_in[j], pos_s)
            o, kb, vb = swa_sample(q, k, v, swa_sinks[j], cache_swa_k[j], cache_swa_v[j], past_len)
            os_ = o @ swa_w_out[j]
            sks.append(kb); svs.append(vb)
        xp = xp + mp[2] * op
        xs = xs + ms[2] * os_
        hp = modulate(rms_norm(xp, norm_ffn_g[i]), mp[3], mp[4])
        hs = modulate(rms_norm(xs, norm_ffn_g[i]), ms[3], ms[4])
        xp = xp + mp[5] * sq_relu_mlp(hp, ffn_w_up[i], ffn_w_down[i])
        xs = xs + ms[5] * sq_relu_mlp(hs, ffn_w_up[i], ffn_w_down[i])
    y_prompt = rms_norm(xp, final_g)
    y_sample = rms_norm(xs, final_g)
    return (y_prompt, y_sample,
            jnp.stack(fkp), jnp.stack(fvp), jnp.stack(flp),
            jnp.stack(fks), jnp.stack(fvs), jnp.stack(fls),
            jnp.stack(skp), jnp.stack(svp),
            jnp.stack(sks), jnp.stack(svs))
```

```cpp
#include <hip/hip_runtime.h>
#include <cstdio>
#include <cstdint>

constexpr int DM = 2048, NB = 2, SEQ = 16384, MP = NB * SEQ, DECB = 16, DECT = 32, MS = DECB * DECT, MT = MP + MS, PAST = 1024, DFF = 8192;
constexpr int FH = 16, FHD = 128, FOX_IN = 3 * DM + FH, FOX_IN_PAD = 6400;
constexpr int SWH = 32, SKV = 4, SHD = 64, SWA_IN = DM + 2 * SKV * SHD, WBUF = 128;
constexpr int NADA = 18, ADAW = 6 * DM;
constexpr float RMS_EPS = 1e-6f;
constexpr int KCROWS = 1088;
constexpr int SROWS = 160;

constexpr size_t O_Y = 0;
constexpr size_t O_FKP = (size_t)MT * DM;
constexpr size_t O_FVP = O_FKP + (size_t)MP * DM;
constexpr size_t O_FLP = O_FVP + (size_t)MP * DM;
constexpr size_t O_FKS = O_FLP + (size_t)MP * FH;
constexpr size_t O_FVS = O_FKS + (size_t)MS * DM;
constexpr size_t O_FLS = O_FVS + (size_t)MS * DM;
constexpr size_t O_SKP = O_FLS + (size_t)MS * FH;
constexpr size_t O_SVP = O_SKP + (size_t)NB * WBUF * 256;
constexpr size_t O_SKS = O_SVP + (size_t)NB * WBUF * 256;
constexpr size_t O_SVS = O_SKS + (size_t)DECB * WBUF * 256;
constexpr size_t O_END = O_SVS + (size_t)DECB * WBUF * 256;

constexpr size_t MiB = 1u << 20;
constexpr size_t WS_CTL = 0, CTL_ZERO_BYTES = 1 * MiB;
constexpr size_t WS_ADA = 1 * MiB;
constexpr size_t WS_ROPE = 3 * MiB;
constexpr size_t WS_SH = 4 * MiB;
constexpr size_t WS_SW0 = 5 * MiB;
constexpr size_t WS_SW1 = 6 * MiB;
constexpr size_t WS_SW2 = 7 * MiB;
constexpr size_t WS_KSC = 8 * MiB;
constexpr size_t WS_VSC = 10 * MiB;
constexpr size_t WS_WFIN = 12 * MiB;
constexpr size_t WS_WFOUT = 37 * MiB;
constexpr size_t WS_WSIN = 45 * MiB;
constexpr size_t WS_WSOUT = 55 * MiB;
constexpr size_t WS_WUP = 63 * MiB;
constexpr size_t WS_WDN = 127 * MiB;
constexpr size_t WS_H = 191 * MiB;
constexpr size_t WS_Q = 321 * MiB;
constexpr size_t WS_K = 451 * MiB;
constexpr size_t WS_V = 581 * MiB;
constexpr size_t WS_O = 711 * MiB;
constexpr size_t WS_A = WS_Q;
constexpr size_t WS_KC = 841 * MiB;
constexpr size_t WS_VC = 909 * MiB;
constexpr size_t WS_CKP = 977 * MiB;
constexpr size_t WS_CQP = 985 * MiB;
constexpr size_t WS_CKS = 993 * MiB;
constexpr size_t WS_CQS = 998 * MiB;
constexpr size_t WS_QN = 1003 * MiB;
constexpr size_t WS_KN = 1005 * MiB;
constexpr size_t WS_SD = 1007 * MiB;
constexpr size_t WS_JLO = 1009 * MiB;
constexpr size_t WS_LFH = 1010 * MiB;
constexpr size_t WS_END = 1012 * MiB;
static_assert((size_t)MT * DM * 2 == 130 * MiB && (size_t)MT * DFF * 2 == 520 * MiB && (size_t)DECB * KCROWS * DM * 2 == 68 * MiB, "map");

constexpr int CW_TMO = 0, CW_CODE = 1, CW_BAR = 4096, CW_DYN = 12288;
constexpr size_t CTL_RSS = 65536;
static_assert(CTL_RSS + 3 * (size_t)MT * 4 <= CTL_ZERO_BYTES, "rss inside the memset region");

#define GAS __attribute__((address_space(1)))
#define LAS __attribute__((address_space(3)))
typedef unsigned short bf16;
typedef unsigned v4u __attribute__((ext_vector_type(4)));
typedef unsigned v2u __attribute__((ext_vector_type(2)));
typedef float f32x4 __attribute__((ext_vector_type(4)));
typedef float f32x16 __attribute__((ext_vector_type(16)));
typedef short bf16x8 __attribute__((ext_vector_type(8)));
typedef short s16x4 __attribute__((ext_vector_type(4)));
typedef GAS unsigned gu32;
#define RLX_AGENT __ATOMIC_RELAXED, __HIP_MEMORY_SCOPE_AGENT
#define LDS_WAIT() asm volatile("s_waitcnt lgkmcnt(0)" ::: "memory")
#define VM_WAIT() asm volatile("s_waitcnt vmcnt(0)" ::: "memory")
__device__ __forceinline__ unsigned cvtpk(float lo, float hi) { unsigned r; asm volatile("v_cvt_pk_bf16_f32 %0, %1, %2" : "=v"(r) : "v"(lo), "v"(hi)); return r; }
__device__ __forceinline__ int arow_of(int row) { return row < MP ? (row >> 14) : 2 + ((row - MP) >> 5); }

__device__ __forceinline__ int fresh_tid() { int t = threadIdx.x; asm volatile("" : "+v"(t)); return t; }
__device__ __forceinline__ size_t tiled_off(int row, int k, int K) {
    const int r = row & 127, c = k & 63, st = (r >> 4) * 2 + (c >> 5), ob = (r & 15) * 64 + (c & 31) * 2;
    return ((size_t)(row >> 7) * (K >> 6) + (k >> 6)) * 16384 + st * 1024 + (ob ^ (((ob >> 9) & 1) << 5));
}
namespace pg8 {
#define PG8_LAS __attribute__((address_space(3)))
typedef unsigned short bf16_t;
typedef short bf16x8 __attribute__((ext_vector_type(8)));
typedef float f32x4 __attribute__((ext_vector_type(4)));
typedef unsigned u32x4 __attribute__((ext_vector_type(4)));
constexpr int BM = 256, BK = 64, HALF = 128, HTB = HALF * BK * 2  , STAGE_BYTES = 8 * HTB, NXCD = 8, WGM = 4;

__host__ __device__ __forceinline__ int lds_byte(int r, int c) { const int st = (r >> 4) * 2 + (c >> 5), rr = r & 15, cc = c & 31, ob = rr * 64 + cc * 2; return st * 1024 + (ob ^ (((ob >> 9) & 1) << 5)); }
__host__ __device__ __forceinline__ void stage_rc(int b, int& R, int& C) { const int st = b / 1024, sb = b % 1024, swz = sb ^ (((sb >> 9) & 1) << 5); R = (st >> 1) * 16 + swz / 64; C = (st & 1) * 32 + (swz % 64) / 2; }
__host__ __device__ __forceinline__ int perm32(int rho) { const int n = rho >> 4, i = rho & 15; return 8 * (i >> 2) + 4 * n + (i & 3); }

struct Unit { int pm, pn; };
struct Gemm { const bf16_t* A; const bf16_t* Bt; int M, N, K; };

struct StaticOrder {
    int nM, nN, nwg, G, c;
    __host__ __device__ void init(int M, int N, int G_, int c_) { nM = M / BM; nN = N / BM; nwg = nM * nN; G = G_; c = c_; }
    __host__ __device__ bool next(int i, Unit& u) const {
        const long L = (long)i * G + c; if (L >= nwg) return false;
        int wgid = (int)L; { const int q = nwg / NXCD, r = nwg % NXCD, xcd = wgid % NXCD, off = wgid / NXCD; wgid = (xcd < r ? xcd * (q + 1) : r * (q + 1) + (xcd - r) * q) + off; }
        const int nig = WGM * nN, gid = wgid / nig, fm = gid * WGM, gsz = (nM - fm) < WGM ? (nM - fm) : WGM;
        u.pm = fm + ((wgid % nig) % gsz); u.pn = (wgid % nig) / gsz; return true;
    }
    __device__ __forceinline__ void a_ready(const Unit&) const {}
    __device__ __forceinline__ int fetch(bool) const { return 0; }
    __device__ __forceinline__ void publish(int, bool, int) const {}
    __device__ __forceinline__ void done(const Unit&) const {}
};

struct DynOrder {
    int nM, nN, q, c, slot; unsigned* ctr;
    __device__ __forceinline__ int pack_tile(int wgid) const { const int nig = WGM * nN, gid = wgid / nig, fm = gid * WGM, gsz = (nM - fm) < WGM ? (nM - fm) : WGM;
        return ((fm + ((wgid % nig) % gsz)) << 8) | ((wgid % nig) / gsz); }
    __device__ __forceinline__ int draw() const { int got = -1;
        for (int k = 0; k < NXCD; ++k) { const int y = (c + k) & 7; const int n = (int)__hip_atomic_fetch_add(ctr + 64 * y, 1u, __ATOMIC_RELAXED, __HIP_MEMORY_SCOPE_AGENT); if (n < q) { got = pack_tile(y * q + n); break; } }
        return got; }
    __device__ __forceinline__ void init(int M, int N, int c_, unsigned* ctr_, int slot_) { nM = M / BM; nN = N / BM; q = nM * nN / NXCD; c = c_; ctr = ctr_; slot = slot_;
        if (threadIdx.x == 0) { const int u0 = draw(); const int u1 = u0 >= 0 ? draw() : -1; *(volatile PG8_LAS int*)(slot) = u0; *(volatile PG8_LAS int*)(slot + 4) = u1; }
        __syncthreads(); }
    __device__ __forceinline__ bool next(int i, Unit& u) const {
        const int v = __builtin_amdgcn_readfirstlane(*(volatile PG8_LAS int*)(slot + 4 * (i & 1))); if (v < 0) return false;
        u.pm = v >> 8; u.pn = v & 255; return true;
    }
    __device__ __forceinline__ void a_ready(const Unit&) const {}
    __device__ __forceinline__ int fetch(bool has_next) const { int got = -1; if (has_next && threadIdx.x == 0) got = draw(); return got; }
    __device__ __forceinline__ void publish(int i, bool has_next, int got) const { if (has_next && threadIdx.x == 0) *(volatile PG8_LAS int*)(slot + 4 * (i & 1)) = got; }
    __device__ __forceinline__ void done(const Unit&) const {}
};
__device__ __forceinline__ unsigned cvt_pk_bf16(float lo, float hi) { unsigned r; asm volatile("v_cvt_pk_bf16_f32 %0, %1, %2" : "=v"(r) : "v"(lo), "v"(hi)); return r; }

typedef unsigned u32x2 __attribute__((ext_vector_type(2)));
__device__ __forceinline__ u32x2 pack4(f32x4 v) { u32x2 w; w.x = cvt_pk_bf16(v[0], v[1]); w.y = cvt_pk_bf16(v[2], v[3]); return w; }

__device__ __forceinline__ u32x4 pack8(f32x4 a, f32x4 b) { u32x4 w; w.x = cvt_pk_bf16(a[0], a[1]); w.y = cvt_pk_bf16(a[2], a[3]); w.z = cvt_pk_bf16(b[0], b[1]); w.w = cvt_pk_bf16(b[2], b[3]); return w; }
struct EpiFoxIn {
    static constexpr bool PERM = true, AFTER_DRAIN = false;
    bf16_t* Q; size_t qkv_stride; float* out;
    __device__ __forceinline__ void operator()(const f32x4 (&acc)[2][2][4][2], const Unit& u, int wr, int wc, int fr, int fq) const {
        const int kind = u.pn >> 3, colt = (u.pn & 7) * 256;
        bf16_t* T = Q + (size_t)kind * qkv_stride; float* o = out + O_FKP + (size_t)(kind - 1) * ((size_t)MP * DM);
#pragma unroll
        for (int ai = 0; ai < 2; ++ai)
#pragma unroll
            for (int m = 0; m < 4; ++m) {
                const int row = u.pm * BM + ai * HALF + wr * 64 + m * 16 + fr;
#pragma unroll
                for (int bj = 0; bj < 2; ++bj) {
                    const int col = colt + bj * HALF + wc * 32 + fq * 8; const f32x4 v0 = acc[ai][bj][m][0], v1 = acc[ai][bj][m][1];
                    *(u32x4*)(T + (size_t)row * DM + col) = pack8(v0, v1);
                    if (kind != 0) { float* op = o + (size_t)row * DM + col; *(f32x4*)op = v0; *(f32x4*)(op + 4) = v1; }
                }
            }
    }
};
template <bool FUSE> struct EpiResid {
    static constexpr bool PERM = true, AFTER_DRAIN = false;
    const float* base; float* X; const float* gate;
    const float* ng; const float* nsc; bf16_t* H; float* rss;
    __device__ __forceinline__ void operator()(const f32x4 (&acc)[2][2][4][2], const Unit& u, int wr, int wc, int fr, int fq) const {
        const int b = u.pm >> 6; const float* gp = gate + (size_t)b * ADAW; const float* sp = nsc + (size_t)b * ADAW;
        f32x4 gv[2][2], cs[2][2];
#pragma unroll
        for (int bj = 0; bj < 2; ++bj)
#pragma unroll
            for (int n = 0; n < 2; ++n) { const int col = u.pn * BM + bj * HALF + wc * 32 + fq * 8 + n * 4; gv[bj][n] = *(const f32x4*)(gp + col);
                if (FUSE) cs[bj][n] = *(const f32x4*)(ng + col) * (*(const f32x4*)(sp + col) + 1.0f); }
#pragma unroll
        for (int ai = 0; ai < 2; ++ai)
#pragma unroll
            for (int m = 0; m < 4; ++m) {
                const int row = u.pm * BM + ai * HALF + wr * 64 + m * 16 + fr;
                const float* bp = base + (size_t)row * DM; float* xp = X + (size_t)row * DM; float ss = 0.f;
#pragma unroll
                for (int bj = 0; bj < 2; ++bj) {
                    const int col = u.pn * BM + bj * HALF + wc * 32 + fq * 8;
                    const f32x4 x0 = *(const f32x4*)(bp + col) + gv[bj][0] * acc[ai][bj][m][0], x1 = *(const f32x4*)(bp + col + 4) + gv[bj][1] * acc[ai][bj][m][1];
                    *(f32x4*)(xp + col) = x0; *(f32x4*)(xp + col + 4) = x1;
                    if (FUSE) { ss += ((x0[0] * x0[0] + x0[1] * x0[1]) + (x0[2] * x0[2] + x0[3] * x0[3])) + ((x1[0] * x1[0] + x1[1] * x1[1]) + (x1[2] * x1[2] + x1[3] * x1[3]));
                        *(u32x4*)((char*)H + tiled_off(row, col, DM)) = pack8(x0 * cs[bj][0], x1 * cs[bj][1]); }
                }
                if (FUSE) { ss += __shfl_xor(ss, 16); ss += __shfl_xor(ss, 32);
                    if (fq == 0) (void)__hip_atomic_fetch_add(rss + row, ss, __ATOMIC_RELAXED, __HIP_MEMORY_SCOPE_AGENT); }
            }
    }
};
struct EpiUp {
    static constexpr bool PERM = true, AFTER_DRAIN = false;
    bf16_t* A; const float* rss; const float* sw;
    __device__ __forceinline__ void operator()(const f32x4 (&acc)[2][2][4][2], const Unit& u, int wr, int wc, int fr, int fq) const {
        const float* swp = sw + (size_t)(u.pm >> 6) * DFF; f32x4 sv[2][2];
#pragma unroll
        for (int bj = 0; bj < 2; ++bj)
#pragma unroll
            for (int n = 0; n < 2; ++n) sv[bj][n] = *(const f32x4*)(swp + u.pn * BM + bj * HALF + wc * 32 + fq * 8 + n * 4);
#pragma unroll
        for (int ai = 0; ai < 2; ++ai)
#pragma unroll
            for (int m = 0; m < 4; ++m) {
                const int row = u.pm * BM + ai * HALF + wr * 64 + m * 16 + fr; bf16_t* ap = A + (size_t)row * DFF;
                const float rstd = 1.0f / sqrtf(rss[row] * (1.0f / DM) + RMS_EPS);
#pragma unroll
                for (int bj = 0; bj < 2; ++bj) {
                    const int col = u.pn * BM + bj * HALF + wc * 32 + fq * 8; f32x4 v0 = acc[ai][bj][m][0] * rstd + sv[bj][0], v1 = acc[ai][bj][m][1] * rstd + sv[bj][1];
#pragma unroll
                    for (int e = 0; e < 4; ++e) { const float r0 = fmaxf(v0[e], 0.f), r1 = fmaxf(v1[e], 0.f); v0[e] = r0 * r0; v1[e] = r1 * r1; }
                    u32x4 w; w.x = cvt_pk_bf16(v0[0], v0[1]); w.y = cvt_pk_bf16(v0[2], v0[3]); w.z = cvt_pk_bf16(v1[0], v1[1]); w.w = cvt_pk_bf16(v1[2], v1[3]);
                    *(u32x4*)((char*)A + tiled_off(row, col, DFF)) = w;
                }
            }
    }
};
struct EpiSwaIn {
    static constexpr bool PERM = true, AFTER_DRAIN = false;
    bf16_t *Q, *K, *V; float* out; const float* rope; const float* rss; const float* sw;
    __device__ __forceinline__ void operator()(const f32x4 (&acc)[2][2][4][2], const Unit& u, int wr, int wc, int fr, int fq) const {
        const int kind = u.pn < 8 ? 0 : (u.pn == 8 ? 1 : 2); const float* swp = sw + (size_t)(u.pm >> 6) * SWA_IN + u.pn * BM;
#pragma unroll
        for (int ai = 0; ai < 2; ++ai)
#pragma unroll
            for (int m = 0; m < 4; ++m) {
                const int row = u.pm * BM + ai * HALF + wr * 64 + m * 16 + fr, t = row & (SEQ - 1);
                const float rstd = 1.0f / sqrtf(rss[row] * (1.0f / DM) + RMS_EPS);
#pragma unroll
                for (int bj = 0; bj < 2; ++bj) {
                    const int c = bj * HALF + wc * 32 + fq * 8;
                    f32x4 v0 = acc[ai][bj][m][0] * rstd + *(const f32x4*)(swp + c), v1 = acc[ai][bj][m][1] * rstd + *(const f32x4*)(swp + c + 4);
                    if (kind != 2 && (wc & 1) == 0) {
                        f32x4 p0, p1;
#pragma unroll
                        for (int e = 0; e < 4; ++e) { p0[e] = __shfl_xor(v0[e], 16); p1[e] = __shfl_xor(v1[e], 16); }
                        const float* rp = rope + (size_t)t * 16;
                        const f32x4 c0 = *(const f32x4*)rp, c1 = *(const f32x4*)(rp + 4), s0 = *(const f32x4*)(rp + 8), s1 = *(const f32x4*)(rp + 12);
                        if (fq == 0) { v0 = v0 * c0 - p0 * s0; v1 = v1 * c1 - p1 * s1; } else if (fq == 1) { v0 = v0 * c0 + p0 * s0; v1 = v1 * c1 + p1 * s1; }
                    }
                    const u32x4 w = pack8(v0, v1);
                    if (kind == 0) { *(u32x4*)(Q + (size_t)row * DM + u.pn * BM + c) = w; }
                    else { bf16_t* T = kind == 1 ? K : V; *(u32x4*)(T + (size_t)row * 256 + c) = w;
                        if (t >= SEQ - WBUF) { float* op = out + (kind == 1 ? O_SKP : O_SVP) + ((size_t)(row >> 14) * WBUF + (t - (SEQ - WBUF))) * 256 + c; *(f32x4*)op = v0; *(f32x4*)(op + 4) = v1; } }
                }
            }
    }
};
template <class Epi, class Sched, bool ALIGN_EPI = false, bool SP2 = false, bool ATILED = false, bool BTILED = false>
__device__ __forceinline__ void gemm_phase(PG8_LAS unsigned char* lds, const Gemm g, const Sched& S, const Epi& E) {
    const int tid = fresh_tid(), wid = __builtin_amdgcn_readfirstlane(tid >> 6), lane = tid & 63, wr = wid >> 2, wc = wid & 3, fr = lane & 15, fq = lane >> 4;
    const int K = g.K, nt = K / BK;
    unsigned voffA[2], voffB[2];
#pragma unroll
    for (int i = 0; i < 2; ++i) { int R, C; stage_rc(tid * 16 + i * 8192, R, C); const int Rb = Epi::PERM ? ((R & ~31) + perm32(R & 31)) : R;
        voffA[i] = ATILED ? (unsigned)(tid * 16 + i * 8192) : (unsigned)(R * K + C) * 2u; voffB[i] = BTILED ? (unsigned)(tid * 16 + i * 8192) : (unsigned)(Rb * K + C) * 2u; }
    const size_t kstepA = ATILED ? (size_t)HTB : (size_t)(BK * 2), kstepB = BTILED ? (size_t)HTB : (size_t)(BK * 2);
    const size_t hstep = (size_t)HALF * K * 2;
    const size_t tstep = 2 * hstep;
    const unsigned ldsw = (unsigned)wid * 1024u;
    const int aoff = lds_byte(wr * 64 + fr, fq * 8), boff = lds_byte(wc * 32 + fr, fq * 8);
#define PG8_SA(b, h) (((b) * 2 + (h)) * HTB)
#define PG8_SB(b, h) ((4 + (b) * 2 + (h)) * HTB)
#define PG8_STAGE(bufoff, gbase, voff) do { _Pragma("unroll") for (int _i = 0; _i < 2; ++_i) \
        __builtin_amdgcn_global_load_lds((const unsigned*)((const char*)(gbase) + (voff)[_i]), (PG8_LAS unsigned*)(lds + (bufoff) + ldsw + _i * 8192), 16, 0, 0); } while (0)
#define PG8_LDA(dst, b, h) do { _Pragma("unroll") for (int m = 0; m < 4; ++m) _Pragma("unroll") for (int k = 0; k < 2; ++k) dst[m][k] = *(const PG8_LAS bf16x8*)(lds + PG8_SA(b, h) + aoff + m * 2048 + k * 1024); } while (0)
#define PG8_LDB(dst, b, h) do { _Pragma("unroll") for (int n = 0; n < 2; ++n) _Pragma("unroll") for (int k = 0; k < 2; ++k) dst[n][k] = *(const PG8_LAS bf16x8*)(lds + PG8_SB(b, h) + boff + n * 2048 + k * 1024); } while (0)
#define PG8_MMA(ai, bj, At, Bt) do { __builtin_amdgcn_s_setprio(1); _Pragma("unroll") for (int m = 0; m < 4; ++m) _Pragma("unroll") for (int n = 0; n < 2; ++n) _Pragma("unroll") for (int k = 0; k < 2; ++k) \
        acc[ai][bj][m][n] = __builtin_amdgcn_mfma_f32_16x16x32_bf16(Bt[n][k], At[m][k], acc[ai][bj][m][n], 0, 0, 0); __builtin_amdgcn_s_setprio(0); } while (0)
#define PG8_WAIT_V(n) asm volatile("s_waitcnt vmcnt(" #n ")" ::: "memory")
#define PG8_WAIT_L(n) asm volatile("s_waitcnt lgkmcnt(" #n ")" ::: "memory")
#define PG8_BAR __builtin_amdgcn_s_barrier()
#define PG8_SCHED __builtin_amdgcn_sched_barrier(0)
    Unit cur, nxt; int ui = 0;
    if (!S.next(0, cur)) return;
    f32x4 acc[2][2][4][2];
#pragma unroll
    for (int a = 0; a < 2; ++a)
#pragma unroll
        for (int b = 0; b < 2; ++b)
#pragma unroll
            for (int m = 0; m < 4; ++m)
#pragma unroll
                for (int n = 0; n < 2; ++n) acc[a][b][m][n] = (f32x4){0.f, 0.f, 0.f, 0.f};
    bf16x8 At[4][2], B0[2][2], B1[2][2];
    const char* cA = (const char*)g.A + (size_t)cur.pm * tstep; const char* cB = (const char*)g.Bt + (size_t)cur.pn * tstep;
    S.a_ready(cur);
    if constexpr (SP2) {
        PG8_STAGE(PG8_SB(0, 0), cB, voffB); PG8_STAGE(PG8_SB(0, 1), cB + hstep, voffB); PG8_STAGE(PG8_SA(0, 0), cA, voffA); PG8_STAGE(PG8_SA(0, 1), cA + hstep, voffA);
        if (wr == 1) PG8_BAR;
        PG8_WAIT_V(2); PG8_BAR;
        PG8_STAGE(PG8_SB(1, 0), cB + kstepB, voffB); PG8_STAGE(PG8_SA(1, 0), cA + kstepA, voffA); PG8_STAGE(PG8_SB(1, 1), cB + hstep + kstepB, voffB);
        PG8_WAIT_V(6); PG8_BAR;
    } else {
        PG8_STAGE(PG8_SB(0, 0), cB, voffB); PG8_STAGE(PG8_SA(0, 0), cA, voffA); PG8_STAGE(PG8_SB(0, 1), cB + hstep, voffB); PG8_STAGE(PG8_SA(0, 1), cA + hstep, voffA);
        if (wr == 1) PG8_BAR;
        PG8_WAIT_V(4); PG8_BAR;
        PG8_STAGE(PG8_SB(1, 0), cB + kstepB, voffB); PG8_STAGE(PG8_SA(1, 0), cA + kstepA, voffA); PG8_STAGE(PG8_SB(1, 1), cB + hstep + kstepB, voffB);
        PG8_WAIT_V(6); PG8_BAR;
    }
    for (;;) {
        bool has_next = false; int fetched = -1;
        const char* nA = cA; const char* nB = cB;
        for (int t = 0; t < nt; t += 2) {
            const bool last = (t == nt - 2);
            if (last) { has_next = S.next(ui + 1, nxt); if (has_next) { nA = (const char*)g.A + (size_t)nxt.pm * tstep; nB = (const char*)g.Bt + (size_t)nxt.pn * tstep; } }
            const char* a1 = cA + (size_t)(t + 1) * kstepA;
            const char* a2 = last ? nA : cA + (size_t)(t + 2) * kstepA; const char* b2 = last ? nB : cB + (size_t)(t + 2) * kstepB;
            const char* a3 = a2 + kstepA; const char* b3 = b2 + kstepB;
            if (last && has_next) S.a_ready(nxt);
            if constexpr (SP2) {
            PG8_LDB(B0, 0, 0); PG8_LDB(B1, 0, 1); PG8_SCHED; PG8_LDA(At, 0, 0); PG8_STAGE(PG8_SA(1, 1), a1 + hstep, voffA);
            PG8_WAIT_V(8); PG8_WAIT_L(0); PG8_BAR; PG8_MMA(0, 0, At, B0); PG8_MMA(0, 1, At, B1); PG8_BAR; PG8_SCHED;
            PG8_LDA(At, 0, 1); PG8_STAGE(PG8_SB(0, 0), b2, voffB); PG8_STAGE(PG8_SB(0, 1), b2 + hstep, voffB); PG8_STAGE(PG8_SA(0, 0), a2, voffA);
            PG8_WAIT_V(8); PG8_WAIT_L(0); PG8_BAR; PG8_MMA(1, 0, At, B0); PG8_MMA(1, 1, At, B1); PG8_BAR; PG8_SCHED;
            PG8_LDB(B0, 1, 0); PG8_LDB(B1, 1, 1); PG8_SCHED; PG8_LDA(At, 1, 0); PG8_STAGE(PG8_SA(0, 1), a2 + hstep, voffA);
            PG8_WAIT_V(8); PG8_WAIT_L(0); PG8_BAR; PG8_MMA(0, 0, At, B0); PG8_MMA(0, 1, At, B1); PG8_BAR; PG8_SCHED;
            PG8_LDA(At, 1, 1); PG8_STAGE(PG8_SB(1, 0), b3, voffB); PG8_STAGE(PG8_SB(1, 1), b3 + hstep, voffB); PG8_STAGE(PG8_SA(1, 0), a3, voffA);
            PG8_WAIT_V(8); PG8_WAIT_L(0); PG8_BAR; PG8_MMA(1, 0, At, B0); PG8_MMA(1, 1, At, B1); PG8_BAR; PG8_SCHED;
            } else {
            PG8_LDB(B0, 0, 0); PG8_SCHED; PG8_LDA(At, 0, 0); PG8_STAGE(PG8_SA(1, 1), a1 + hstep, voffA);
            PG8_WAIT_L(8); PG8_BAR; PG8_WAIT_L(0); PG8_MMA(0, 0, At, B0); PG8_BAR; PG8_SCHED;
            PG8_LDB(B1, 0, 1); PG8_STAGE(PG8_SB(0, 0), b2, voffB);
            PG8_BAR; PG8_WAIT_L(0); PG8_MMA(0, 1, At, B1); PG8_BAR;
            PG8_LDA(At, 0, 1); PG8_STAGE(PG8_SA(0, 0), a2, voffA);
            PG8_BAR; PG8_WAIT_L(0); PG8_MMA(1, 0, At, B0); PG8_BAR; PG8_SCHED;
            PG8_STAGE(PG8_SB(0, 1), b2 + hstep, voffB);
            PG8_WAIT_V(6); PG8_BAR; PG8_MMA(1, 1, At, B1); PG8_BAR;
            PG8_LDB(B0, 1, 0); PG8_SCHED; PG8_LDA(At, 1, 0); PG8_STAGE(PG8_SA(0, 1), a2 + hstep, voffA);
            PG8_WAIT_L(8); PG8_BAR; PG8_WAIT_L(0); PG8_MMA(0, 0, At, B0); PG8_BAR; PG8_SCHED;
            PG8_LDB(B1, 1, 1); PG8_STAGE(PG8_SB(1, 0), b3, voffB);
            PG8_BAR; PG8_WAIT_L(0); PG8_MMA(0, 1, At, B1); PG8_BAR;
            PG8_LDA(At, 1, 1); PG8_STAGE(PG8_SA(1, 0), a3, voffA);
            PG8_BAR; PG8_WAIT_L(0); PG8_MMA(1, 0, At, B0); PG8_BAR; PG8_SCHED;
            PG8_STAGE(PG8_SB(1, 1), b3 + hstep, voffB);
            PG8_WAIT_V(6); PG8_BAR; PG8_MMA(1, 1, At, B1); PG8_BAR;
            }
        }
        if constexpr (ALIGN_EPI) { if (wr == 0) PG8_BAR; }
        if constexpr (!Epi::AFTER_DRAIN) { fetched = S.fetch(has_next); E(acc, cur, wr, wc, fr, fq); S.publish(ui, has_next, fetched); S.done(cur); }
        if (!has_next) break;
#pragma unroll
        for (int a = 0; a < 2; ++a)
#pragma unroll
            for (int b = 0; b < 2; ++b)
#pragma unroll
                for (int m = 0; m < 4; ++m)
#pragma unroll
                    for (int n = 0; n < 2; ++n) acc[a][b][m][n] = (f32x4){0.f, 0.f, 0.f, 0.f};
        cur = nxt; cA = nA; cB = nB; ++ui;
        if constexpr (ALIGN_EPI) { if (wr == 1) PG8_BAR; }
    }
    PG8_WAIT_V(0);
    if constexpr (!ALIGN_EPI) { if (wr == 0) PG8_BAR; }
    PG8_BAR;
    if constexpr (Epi::AFTER_DRAIN) { E.fused(acc, cur, wr, wc, fr, fq, lds, wid, lane); S.done(cur); }
#undef PG8_SA
#undef PG8_SB
#undef PG8_STAGE
#undef PG8_LDA
#undef PG8_LDB
#undef PG8_MMA
#undef PG8_WAIT_V
#undef PG8_WAIT_L
#undef PG8_BAR
#undef PG8_SCHED
}
}

namespace fox {
constexpr int D = 128, PITCH = 2048;
constexpr float SCALE = 0.08838834764831845f;
constexpr float THR = 8.f;
constexpr int NW = 8, QBLK = 32, KVBLK = 64, QB = NW * QBLK;
constexpr int SHM_V = KVBLK * D * 2, SHM_K = KVBLK * D * 2;
constexpr int OFF_WS = 2 * SHM_V + 2 * SHM_K, OFF_C = OFF_WS + NW * 64 * 4, LDS_BYTES = OFF_C + 3104;
#define KSWZ(row, colB) ((row) * 256 + ((colB) ^ (((row) & 7) << 4)))
#define SBAR() __builtin_amdgcn_sched_barrier(0)
__device__ __forceinline__ int v_st(int k, int c) { const int kk = (k & ~0xC) | ((k & 4) << 1) | ((k & 8) >> 1); return ((kk >> 3) * 4 + (c >> 5)) * 512 + ((kk & 7) * 32 + (c & 31)) * 2; }
__device__ __forceinline__ int v_rd_base(int lane) { return ((lane & 3) << 3) | (((lane >> 2) & 3) << 6) | (((lane >> 4) & 1) << 5) | (((lane >> 5) & 1) << 8); }
constexpr int v_rd_off(int d0, int ks, int half) { return d0 * 512 + ks * 4096 + half * 2048; }
__device__ __forceinline__ int crow(int r, int hi) { return (r & 3) + 8 * (r >> 2) + 4 * hi; }
__device__ __forceinline__ bf16x8 load8(const bf16* p) { return *reinterpret_cast<const bf16x8*>(p); }
__device__ __forceinline__ void mask_tile(f32x16& p0, f32x16& p1, int dq) {
    const float NEG = -__builtin_inff();
#pragma unroll
    for (int r = 0; r < 16; ++r) {
        const int c = (r & 3) + 8 * (r >> 2);
        if (dq - c < 0) p0[r] = NEG;
        if (dq - c - 32 < 0) p1[r] = NEG;
    }
}
__device__ __forceinline__ void partialSM(f32x16& p0, f32x16& p1, float& m_reg, float& mn, float& alpha) {
    float pmax = p0[0]; for (int r = 1; r < 16; ++r) pmax = fmaxf(pmax, p0[r]); for (int r = 0; r < 16; ++r) pmax = fmaxf(pmax, p1[r]);
    { auto rr = __builtin_amdgcn_permlane32_swap(__float_as_uint(pmax), __float_as_uint(pmax), false, false);
      pmax = fmaxf(__uint_as_float(rr[0]), __uint_as_float(rr[1])); }
    constexpr float C2 = 1.4426950408889634f * SCALE;
    if (__builtin_expect(__all((pmax - m_reg) * SCALE <= THR), 1)) { mn = m_reg; alpha = 1.f; }
    else { mn = fmaxf(m_reg, pmax); alpha = __builtin_amdgcn_exp2f((m_reg - mn) * C2); m_reg = mn; }
    const float mnL = -mn * C2;
    for (int r = 0; r < 16; ++r) p0[r] = fmaf(p0[r], C2, mnL); for (int r = 0; r < 16; ++r) p1[r] = fmaf(p1[r], C2, mnL);
    for (int r = 0; r < 16; ++r) p0[r] = __builtin_amdgcn_exp2f(p0[r]);
}
__device__ __forceinline__ void finishSM(f32x16& p0, f32x16& p1, float alpha, float& l_reg, bf16x8& pa0, bf16x8& pa1, bf16x8& pa2, bf16x8& pa3) {
    for (int r = 0; r < 16; ++r) p1[r] = __builtin_amdgcn_exp2f(p1[r]);
    float ps = 0; for (int r = 0; r < 16; ++r) ps += p0[r]; for (int r = 0; r < 16; ++r) ps += p1[r];
    { auto rr = __builtin_amdgcn_permlane32_swap(__float_as_uint(ps), __float_as_uint(ps), false, false);
      ps = __uint_as_float(rr[0]) + __uint_as_float(rr[1]); }
    l_reg = l_reg * alpha + ps;
#define PK4(P, B_, OUT) do { unsigned a0 = cvtpk(P[B_+0], P[B_+1]), a1 = cvtpk(P[B_+2], P[B_+3]);                          \
        unsigned b0 = cvtpk(P[B_+4], P[B_+5]), b1 = cvtpk(P[B_+6], P[B_+7]);                                             \
        auto r0 = __builtin_amdgcn_permlane32_swap(a0, b0, false, false); auto r1 = __builtin_amdgcn_permlane32_swap(a1, b1, false, false); \
        v4u w = {r0[0], r1[0], r0[1], r1[1]}; OUT = *reinterpret_cast<bf16x8*>(&w); } while (0)
    PK4(p0, 0, pa0); PK4(p0, 8, pa1); PK4(p1, 0, pa2); PK4(p1, 8, pa3);
}
template <int KB>
__device__ __forceinline__ void qkt(f32x16& p0, f32x16& p1, const char* K_lds, const char* C_lds, int r32, int hi, const bf16x8* qr, bf16x8 cqf, int caddr) {
    const bf16x8 ca = *reinterpret_cast<const bf16x8*>(C_lds + KB * 1024 + caddr);
    const bf16x8 cb = *reinterpret_cast<const bf16x8*>(C_lds + KB * 1024 + caddr + (hi ? 0 : 512));
    p0 = __builtin_amdgcn_mfma_f32_32x32x16_bf16(ca, cqf, f32x16{}, 0, 0, 0);
    p1 = __builtin_amdgcn_mfma_f32_32x32x16_bf16(cb, cqf, f32x16{}, 0, 0, 0);
    const char* kb[4];
#pragma unroll
    for (int dd = 0; dd < 4; ++dd) kb[dd] = K_lds + KB * SHM_K + KSWZ(r32, (dd * 16 + hi * 8) * 2);
#pragma unroll
    for (int d0 = 0; d0 < 8; ++d0) { const char* a = kb[d0 & 3] + (d0 >> 2) * 128;
        bf16x8 b0 = *reinterpret_cast<const bf16x8*>(a);
        bf16x8 b1 = *reinterpret_cast<const bf16x8*>(a + 32 * 256);
        p0 = __builtin_amdgcn_mfma_f32_32x32x16_bf16(b0, qr[d0], p0, 0, 0, 0);
        p1 = __builtin_amdgcn_mfma_f32_32x32x16_bf16(b1, qr[d0], p1, 0, 0, 0); }
}
template <int VB>
__device__ __forceinline__ void pv_tile(f32x16* o, int vb0, bf16x8 pa0, bf16x8 pa1, bf16x8 pa2, bf16x8 pa3) {
#define TRRD(dst, off) asm volatile("ds_read_b64_tr_b16 %0, %1 offset:%2" : "=&v"(dst) : "v"(vb0), "i"(off) : "memory")
#define PV_D0(d0) do { s16x4 l0, l1, l2, l3, h0, h1, h2, h3; constexpr int b_ = VB * SHM_V + v_rd_off(d0, 0, 0); \
        TRRD(l0, b_); TRRD(h0, b_ + 2048); TRRD(l1, b_ + 4096); TRRD(h1, b_ + 6144); TRRD(l2, b_ + 8192); TRRD(h2, b_ + 10240); TRRD(l3, b_ + 12288); TRRD(h3, b_ + 14336); \
        asm volatile("s_waitcnt lgkmcnt(0)" ::: "memory"); SBAR();   \
        o[d0] = __builtin_amdgcn_mfma_f32_32x32x16_bf16(pa0, (bf16x8){l0[0], l0[1], l0[2], l0[3], h0[0], h0[1], h0[2], h0[3]}, o[d0], 0, 0, 0);   \
        o[d0] = __builtin_amdgcn_mfma_f32_32x32x16_bf16(pa1, (bf16x8){l1[0], l1[1], l1[2], l1[3], h1[0], h1[1], h1[2], h1[3]}, o[d0], 0, 0, 0);   \
        o[d0] = __builtin_amdgcn_mfma_f32_32x32x16_bf16(pa2, (bf16x8){l2[0], l2[1], l2[2], l2[3], h2[0], h2[1], h2[2], h2[3]}, o[d0], 0, 0, 0);   \
        o[d0] = __builtin_amdgcn_mfma_f32_32x32x16_bf16(pa3, (bf16x8){l3[0], l3[1], l3[2], l3[3], h3[0], h3[1], h3[2], h3[3]}, o[d0], 0, 0, 0); } while (0)
    PV_D0(0); PV_D0(1); PV_D0(2); PV_D0(3);
#undef PV_D0
#undef TRRD
}
struct BlockRef { unsigned q0, k0, c0; int P0, wstride, jlo, jhi, samp; };
struct Tensors { const bf16* Q; const bf16* K; const bf16* V; bf16* O; const bf16* KC; const bf16* VC; const bf16* CKP; const bf16* CQP; const bf16* CKS; const bf16* CQS; const int* JLO; };
#define BR_Q(r) (T.Q + (r).q0)
#define BR_O(r) (T.O + (r).q0)
#define BR_K(r) (((r).samp ? T.KC : T.K) + (r).k0)
#define BR_V(r) (((r).samp ? T.VC : T.V) + (r).k0)
#define BR_CK(r) (((r).samp ? T.CKS : T.CKP) + (r).c0)
#define BR_CQ(r) (((r).samp ? T.CQS : T.CQP) + (r).c0)
struct Seam { bf16x8 qr[8]; bf16x8 st_v0, st_v1, st_k0, st_k1; bf16x8 cqf; };
#define VMW() asm volatile("s_waitcnt vmcnt(0)" ::: "memory")
#define VMWN(n) asm volatile("s_waitcnt vmcnt(%0)" :: "i"(n) : "memory")
#define SLOAD_H(Kp, Vp, Cp, k0) do { const bf16* vb_ = (Vp) + (size_t)(k0) * PITCH; const bf16* kb_ = (Kp) + (size_t)(k0) * PITCH;              \
                         S.st_v0 = load8(vb_ + loff); S.st_v1 = load8(vb_ + 32 * PITCH + loff);              \
                         S.st_k0 = load8(kb_ + loff); S.st_k1 = load8(kb_ + 32 * PITCH + loff); } while (0)
#define SWRITE_HK(bf) do { *(bf16x8*)(K_lds + (bf) * SHM_K + kws) = S.st_k0; *(bf16x8*)(K_lds + (bf) * SHM_K + kws + 32 * 256) = S.st_k1; } while (0)
#define CDMA(Cp, k0, bf) do { if (wid == 0) __builtin_amdgcn_global_load_lds((const unsigned*)((const char*)((Cp) + (size_t)(k0) * 8) + coff), (LAS unsigned*)(C_lds + (bf) * 1024), 16, 0, 0); } while (0)
#define SWRITE_HV(bf) do { *(bf16x8*)(V_lds + (bf) * SHM_V + vst0) = S.st_v0; *(bf16x8*)(V_lds + (bf) * SHM_V + vst1) = S.st_v1; } while (0)
#define SWRITE_H(bf) do { SWRITE_HV(bf); SWRITE_HK(bf); } while (0)
__device__ __forceinline__ void fox_prime(const BlockRef& cur, const Tensors& T, char* lds, Seam& S) {
    const int tid = fresh_tid(), wid = __builtin_amdgcn_readfirstlane(tid >> 6), lane = tid & 63, r32 = lane & 31, hi = lane >> 5;
    const int sr = tid >> 4, sc = (tid & 15) * 8, kws = KSWZ(sr, sc * 2); char* K_lds = lds + 2 * SHM_V; char* C_lds = lds + OFF_C;
    const unsigned loff = (unsigned)(sr * PITCH + sc), qoff = (unsigned)(r32 * PITCH + hi * 8), coff = (unsigned)lane * 16u;
    if (tid < 8) { *(unsigned*)(C_lds + 2048 + (tid & 3) * 4 + (tid >> 2) * 1024) = 0u; }
    { const bf16* qb_ = BR_Q(cur) + (size_t)(wid * cur.wstride) * PITCH;
      for (int d0 = 0; d0 < 8; ++d0) S.qr[d0] = load8(qb_ + qoff + d0 * 16); }
    S.cqf = (bf16x8){0, 0, 0, 0, 0, 0, 0, 0};
    if (hi == 0) S.cqf = load8(BR_CQ(cur) + (size_t)(cur.P0 + wid * cur.wstride) * 8 + (unsigned)(r32 * 8));
    CDMA(BR_CK(cur), cur.jlo * KVBLK, 0);
    SLOAD_H(BR_K(cur), BR_V(cur), 0, cur.jlo * KVBLK); VMW(); SWRITE_HK(0);
    __syncthreads();
}
template <bool SAMP>
__device__ __forceinline__ void fox_block(const BlockRef& cur, const BlockRef& nxt, const Tensors& T, char* lds, Seam& S) {
    const int tid = fresh_tid(), wid = __builtin_amdgcn_readfirstlane(tid >> 6), lane = tid & 63, r32 = lane & 31, hi = lane >> 5;
    const int NT = cur.jhi - cur.jlo, j_lo = cur.jlo;
    const bool act = !SAMP || wid == 0;
#define ACTV(x) do { if (act) { x; } } while (0)
    const int qlo = cur.P0 + wid * cur.wstride, qm = qlo + r32 - 4 * hi;
    char* V_lds = lds; char* K_lds = lds + 2 * SHM_V; char* C_lds = lds + OFF_C;
    float* ws = (float*)(lds + OFF_WS) + wid * 64; float* li_l = ws, * al_l = ws + 32;
    float m_reg = -1e30f, l_reg = 0; f32x16 o[4] = {};
    const int sr = tid >> 4, sc = (tid & 15) * 8, vst0 = v_st(sr, sc), vst1 = v_st(32 + sr, sc), kws = KSWZ(sr, sc * 2);
    const int vb0 = (int)(uintptr_t)V_lds + v_rd_base(lane);
    const int caddr = hi ? 2048 : r32 * 16;
    const unsigned loff = (unsigned)(sr * PITCH + sc), qoff = (unsigned)(r32 * PITCH + hi * 8), coff = (unsigned)lane * 16u;
    const bf16* Kh = BR_K(cur); const bf16* Vh = BR_V(cur); const bf16* Ch = BR_CK(cur); const bf16x8 cqf = S.cqf;
#define RESC(a) do { if (__any((a) < 1.f)) { if (hi == 0) al_l[r32] = (a); asm volatile("s_waitcnt lgkmcnt(0)" ::: "memory");              \
                     for (int d_ = 0; d_ < 4; ++d_) for (int r = 0; r < 16; ++r) o[d_][r] *= al_l[crow(r, hi)]; } } while (0)
#define KBASE(t) ((j_lo + (t)) * KVBLK)
#define MASKT(P0_, P1_, t) do { const int kb_ = KBASE(t); if (kb_ + KVBLK - 1 > qlo) mask_tile(P0_, P1_, qm - kb_); } while (0)
    constexpr int NQL = 9;
#define SEAM_K0() do { VMWN(NQL); SWRITE_HK(0); SBAR(); } while (0)
    f32x16 pA0, pA1, pB0, pB1; float mnA, mnB, alA, alB; bf16x8 pa0, pa1, pa2, pa3;
    SWRITE_HV(0); SBAR();
    if (NT > 1) { CDMA(Ch, KBASE(1), 1); SLOAD_H(Kh, Vh, Ch, KBASE(1)); }
    SBAR(); ACTV(qkt<0>(pA0, pA1, K_lds, C_lds, r32, hi, S.qr, cqf, caddr);
    MASKT(pA0, pA1, 0); partialSM(pA0, pA1, m_reg, mnA, alA));
    if (NT > 1) { VMW(); SWRITE_H(1); }
    __syncthreads();
#define HALF_STEP(PX0, PX1, mnX, alX, PY0, PY1, alY, t, KB, VB, SB) do {                                                      \
        SBAR(); ACTV(qkt<KB>(PX0, PX1, K_lds, C_lds, r32, hi, S.qr, cqf, caddr);                                             \
        finishSM(PY0, PY1, alY, l_reg, pa0, pa1, pa2, pa3)); SBAR();                                                           \
        if ((t) + 1 < NT) { CDMA(Ch, KBASE((t) + 1), SB); SLOAD_H(Kh, Vh, Ch, KBASE((t) + 1)); SBAR(); }                                               \
        ACTV(pv_tile<VB>(o, vb0, pa0, pa1, pa2, pa3); MASKT(PX0, PX1, (t)); partialSM(PX0, PX1, m_reg, mnX, alX));                                        \
        __syncthreads();                                                                                                      \
        if ((t) + 1 < NT) { VMW(); SWRITE_H(SB); }                                                                          \
        ACTV(RESC(alX)); __syncthreads(); } while (0)
    for (int t = 1; t + 1 < NT; t += 2) {
        HALF_STEP(pB0, pB1, mnB, alB, pA0, pA1, alA, t, 1, 0, 0);
        HALF_STEP(pA0, pA1, mnA, alA, pB0, pB1, alB, t + 1, 0, 1, 1);
    }
    const bool even = (NT & 1) == 0;
    if (even) { SBAR(); ACTV(qkt<1>(pB0, pB1, K_lds, C_lds, r32, hi, S.qr, cqf, caddr)); SBAR(); }
    CDMA(BR_CK(nxt), nxt.jlo * KVBLK, 0); SLOAD_H(BR_K(nxt), BR_V(nxt), 0, nxt.jlo * KVBLK); SBAR();
    { const bf16* qb_ = BR_Q(nxt) + (size_t)(wid * nxt.wstride) * PITCH;
#pragma unroll
      for (int d0 = 0; d0 < 8; ++d0) S.qr[d0] = load8(qb_ + qoff + d0 * 16); }
    S.cqf = (bf16x8){0, 0, 0, 0, 0, 0, 0, 0};
    if (hi == 0) S.cqf = load8(BR_CQ(nxt) + (size_t)(nxt.P0 + wid * nxt.wstride) * 8 + (unsigned)(r32 * 8));
    SBAR();
    ACTV(finishSM(pA0, pA1, alA, l_reg, pa0, pa1, pa2, pa3)); SBAR();
    ACTV(pv_tile<0>(o, vb0, pa0, pa1, pa2, pa3));
    if (even) { ACTV(MASKT(pB0, pB1, NT - 1); partialSM(pB0, pB1, m_reg, mnB, alB)); __syncthreads(); ACTV(RESC(alB);
        finishSM(pB0, pB1, alB, l_reg, pa0, pa1, pa2, pa3)); SBAR(); ACTV(pv_tile<1>(o, vb0, pa0, pa1, pa2, pa3)); }
    SBAR(); SEAM_K0();
    if (hi == 0) li_l[r32] = l_reg; asm volatile("s_waitcnt lgkmcnt(0)" ::: "memory");
    float rli[16];
#pragma unroll
    for (int r = 0; r < 16; ++r) rli[r] = __builtin_amdgcn_rcpf(li_l[crow(r, hi)]);
    __syncthreads();
    if (cur.wstride != 0 || wid == 0) {
        bf16* Ow = BR_O(cur) + (size_t)(wid * cur.wstride) * PITCH; char* stg = V_lds + wid * 4096;
        const unsigned srow = (unsigned)(lane >> 3), sch = (unsigned)(lane & 7);
#pragma unroll
        for (int h2 = 0; h2 < 2; ++h2) {
#pragma unroll
            for (int r = 0; r < 16; ++r) { const int orow = crow(r, hi);
#pragma unroll
                for (int d0 = 0; d0 < 2; ++d0) *(bf16*)(stg + orow * 128 + (d0 * 32 + r32) * 2) = (bf16)(cvtpk(o[2 * h2 + d0][r] * rli[r], 0.f) & 0xffffu); }
            asm volatile("s_waitcnt lgkmcnt(0)" ::: "memory");
#pragma unroll
            for (int i = 0; i < 4; ++i) { const unsigned row = i * 8 + srow; const v4u v = *(const v4u*)(stg + row * 128 + sch * 16);
                *(v4u*)(Ow + (size_t)row * PITCH + h2 * 64 + sch * 8) = v; }
            asm volatile("s_waitcnt lgkmcnt(0)" ::: "memory");
        }
    }
    __syncthreads();
#undef ACTV
#undef RESC
#undef KBASE
#undef MASKT
#undef SEAM_K0
#undef HALF_STEP
}
#undef VMW
#undef VMWN
#undef SLOAD_H
#undef SWRITE_HK
#undef SWRITE_HV
#undef SWRITE_H
#undef CDMA
#undef PK4
#undef KSWZ
__device__ __forceinline__ BlockRef fox_ref(int L, int pass, const int* JLO) {
    BlockRef r;
    if (L < 1024) { const int i = L >> 8, v = L & 255, bh = (v >> 5) + 8 * i, j = v & 31, qb = pass == 0 ? 63 - j : j, b = bh >> 4, h = bh & 15;
        r.q0 = (unsigned)((b * SEQ + qb * QB) * PITCH + h * D); r.k0 = (unsigned)(b * SEQ * PITCH + h * D); r.c0 = (unsigned)(bh * SEQ * 8); r.P0 = qb * QB; r.wstride = QBLK; r.jhi = 4 * (qb + 1); r.samp = 0; r.jlo = JLO[bh * (SEQ / QB) + qb]; }
    else { const int s = L - 1024, b = s >> 4, h = s & 15;
        r.q0 = (unsigned)((MP + b * DECT) * PITCH + h * D); r.k0 = (unsigned)(b * KCROWS * PITCH + h * D); r.c0 = (unsigned)(s * KCROWS * 8); r.P0 = PAST; r.wstride = 0; r.jhi = (PAST + DECT + KVBLK - 1) / KVBLK; r.samp = 1; r.jlo = 0; }
    return r;
}
__device__ __forceinline__ void fox_phase(char* lds, const Tensors& T, int vcu, int G) {
    constexpr int TOTAL = 1024 + DECB * FH;
    int L = vcu; if (L >= TOTAL) return;
    int pass = 0;
    BlockRef cur = fox_ref(L, 0, T.JLO);
    Seam S;
    fox_prime(cur, T, lds, S);
    bool done = false;
    while (!cur.samp) {
        const bool more_pass = pass == 0, more_item = L + G < TOTAL, last = !more_pass && !more_item;
        int passn = pass + 1, Ln = L;
        if (!more_pass) { passn = 0; Ln = more_item ? L + G : L; }
        const BlockRef nxt = last ? cur : fox_ref(Ln, passn, T.JLO);
        fox_block<false>(cur, nxt, T, lds, S);
        if (last) { done = true; break; }
        cur = nxt; pass = passn; L = Ln;
    }
    while (!done) {
        const bool more_item = L + G < TOTAL; const int Ln = more_item ? L + G : L;
        const BlockRef nxt = more_item ? fox_ref(Ln, 0, T.JLO) : cur;
        fox_block<true>(cur, nxt, T, lds, S);
        if (!more_item) break;
        cur = nxt; L = Ln;
    }
}
#undef SBAR
#undef BR_Q
#undef BR_O
#undef BR_K
#undef BR_V
#undef BR_CK
#undef BR_CQ
}

namespace swa {
constexpr int NKMAX = 192, LDS_K = 0, LDS_V = NKMAX * 128, LDS_WS = 2 * NKMAX * 128, OST_OFF = 65536, LDS_BYTES = OST_OFF + 8 * 4096;
constexpr float C2 = 0.125f * 1.4426950408889634f, LOG2E = 1.4426950408889634f;
__device__ __forceinline__ int k_off(int row, int chunk) { return row * 128 + ((chunk ^ ((row >> 1) & 7)) << 4); }
__device__ __forceinline__ int v_st(int k, int c) { const int kk = (k & ~0xC) | ((k & 4) << 1) | ((k & 8) >> 1); return ((kk >> 3) * 2 + (c >> 5)) * 512 + ((kk & 7) * 32 + (c & 31)) * 2; }
__device__ __forceinline__ int v_rd_base(int lane) { return ((lane & 3) << 3) | (((lane >> 2) & 3) << 6) | (((lane >> 4) & 1) << 5) | (((lane >> 5) & 1) << 8); }
__device__ __forceinline__ int crow(int r, int hi) { return (r & 3) + 8 * (r >> 2) + 4 * hi; }
struct Tensors { const bf16* Q; const bf16* K; const bf16* V; bf16* O; const bf16* KSC; const bf16* VSC; const float* sinks; };
#define SWA_PK4(P, B_, OUT) do { unsigned a0 = cvtpk(P[B_+0], P[B_+1]), a1 = cvtpk(P[B_+2], P[B_+3]);                          \
        unsigned b0 = cvtpk(P[B_+4], P[B_+5]), b1 = cvtpk(P[B_+6], P[B_+7]);                                             \
        auto r0 = __builtin_amdgcn_permlane32_swap(a0, b0, false, false); auto r1 = __builtin_amdgcn_permlane32_swap(a1, b1, false, false); \
        v4u w = {r0[0], r1[0], r0[1], r1[1]}; OUT = *reinterpret_cast<bf16x8*>(&w); } while (0)
#define SWA_TRRD(dst, off) asm volatile("ds_read_b64_tr_b16 %0, %1 offset:%2" : "=&v"(dst) : "v"(vb0), "i"(off) : "memory")
template <int KB> __device__ __forceinline__ void pv_kb(f32x16* o, const f32x16& p, int vb0) {
    bf16x8 paL, paH; SWA_PK4(p, 0, paL); SWA_PK4(p, 8, paH);
#define SWA_PV_D0(d0) do { s16x4 l0, h0, l1, h1; constexpr int b_ = (d0) * 512 + (2 * KB) * 2048; \
        SWA_TRRD(l0, b_); SWA_TRRD(h0, b_ + 1024); SWA_TRRD(l1, b_ + 2048); SWA_TRRD(h1, b_ + 3072); \
        asm volatile("s_waitcnt lgkmcnt(0)" ::: "memory"); __builtin_amdgcn_sched_barrier(0); \
        o[d0] = __builtin_amdgcn_mfma_f32_32x32x16_bf16(paL, (bf16x8){l0[0], l0[1], l0[2], l0[3], h0[0], h0[1], h0[2], h0[3]}, o[d0], 0, 0, 0); \
        o[d0] = __builtin_amdgcn_mfma_f32_32x32x16_bf16(paH, (bf16x8){l1[0], l1[1], l1[2], l1[3], h1[0], h1[1], h1[2], h1[3]}, o[d0], 0, 0, 0); } while (0)
    SWA_PV_D0(0); SWA_PV_D0(1);
#undef SWA_PV_D0
}
__device__ __forceinline__ void swa_unit(int u, const Tensors& T, char* lds) {
    const int tid = fresh_tid(), wid = __builtin_amdgcn_readfirstlane(tid >> 6), lane = tid & 63, r32 = lane & 31, hi = lane >> 5;
    int ntok, NK, kvh; size_t qrow0; const bf16* Kp; const bf16* Vp;
    if (u < NB * (SEQ / 64) * SKV) { const int b = u / ((SEQ / 64) * SKV), rem = u % ((SEQ / 64) * SKV), c = rem >> 2; kvh = rem & 3;
        const int nprev = c < 2 ? c : 2; ntok = 64; NK = 64 * (nprev + 1); qrow0 = (size_t)b * SEQ + (size_t)c * 64;
        const size_t kr0 = qrow0 - 64 * nprev; Kp = T.K + kr0 * 256 + kvh * 64; Vp = T.V + kr0 * 256 + kvh * 64; }
    else { const int s = u - NB * (SEQ / 64) * SKV, b = s >> 2; kvh = s & 3; ntok = DECT; NK = SROWS; qrow0 = (size_t)MP + (size_t)b * DECT;
        Kp = T.KSC + (size_t)b * SROWS * 256 + kvh * 64; Vp = T.VSC + (size_t)b * SROWS * 256 + kvh * 64; }
    char* K_lds = lds + LDS_K; char* V_lds = lds + LDS_V; float* wsf = (float*)(lds + LDS_WS) + wid * 32;
#pragma unroll
    for (int i = 0; i < 3; ++i) { const int idx = tid + 512 * i, row = idx >> 3, ch = idx & 7;
        bf16x8 kv = {0, 0, 0, 0, 0, 0, 0, 0}, vv = {0, 0, 0, 0, 0, 0, 0, 0};
        if (row < NK) { kv = *(const bf16x8*)(Kp + (size_t)row * 256 + ch * 8); vv = *(const bf16x8*)(Vp + (size_t)row * 256 + ch * 8); }
        *(bf16x8*)(K_lds + k_off(row, ch)) = kv; *(bf16x8*)(V_lds + v_st(row, ch * 8)) = vv; }
    __syncthreads();
    const int vb0 = (int)(uintptr_t)V_lds + v_rd_base(lane);
    const int head = kvh * 8 + wid;
    const float sink2 = T.sinks[head] * LOG2E;
    for (int qb = 0; qb < ntok / 32; ++qb) {
        const bf16* qp = T.Q + (qrow0 + qb * 32 + r32) * DM + head * SHD + hi * 8;
        bf16x8 qf[4];
#pragma unroll
        for (int d0 = 0; d0 < 4; ++d0) qf[d0] = *(const bf16x8*)(qp + d0 * 16);
        f32x16 s[6];
#pragma unroll
        for (int kb = 0; kb < 6; ++kb) {
            if (kb * 32 < NK) {
                s[kb] = f32x16{};
#pragma unroll
                for (int d0 = 0; d0 < 4; ++d0) { const bf16x8 a = *(const bf16x8*)(K_lds + k_off(kb * 32 + r32, d0 * 2 + hi));
                    s[kb] = __builtin_amdgcn_mfma_f32_32x32x16_bf16(a, qf[d0], s[kb], 0, 0, 0); }
            } else {
#pragma unroll
                for (int r = 0; r < 16; ++r) s[kb][r] = -__builtin_inff();
            }
        }
        float mx = s[0][0];
#pragma unroll
        for (int kb = 0; kb < 6; ++kb)
#pragma unroll
            for (int r = 0; r < 16; ++r) mx = fmaxf(mx, s[kb][r]);
        { auto rr = __builtin_amdgcn_permlane32_swap(__float_as_uint(mx), __float_as_uint(mx), false, false); mx = fmaxf(__uint_as_float(rr[0]), __uint_as_float(rr[1])); }
        const float m2 = fmaxf(mx * C2, sink2);
        float ps = 0.f;
#pragma unroll
        for (int kb = 0; kb < 6; ++kb)
#pragma unroll
            for (int r = 0; r < 16; ++r) { const float p = __builtin_amdgcn_exp2f(fmaf(s[kb][r], C2, -m2)); s[kb][r] = p; ps += p; }
        { auto rr = __builtin_amdgcn_permlane32_swap(__float_as_uint(ps), __float_as_uint(ps), false, false); ps = __uint_as_float(rr[0]) + __uint_as_float(rr[1]); }
        const float den = ps + __builtin_amdgcn_exp2f(sink2 - m2);
        f32x16 o[2] = {};
        if (0 * 32 < NK) pv_kb<0>(o, s[0], vb0);
        if (1 * 32 < NK) pv_kb<1>(o, s[1], vb0);
        if (2 * 32 < NK) pv_kb<2>(o, s[2], vb0);
        if (3 * 32 < NK) pv_kb<3>(o, s[3], vb0);
        if (4 * 32 < NK) pv_kb<4>(o, s[4], vb0);
        if (5 * 32 < NK) pv_kb<5>(o, s[5], vb0);
        if (hi == 0) wsf[r32] = den; asm volatile("s_waitcnt lgkmcnt(0)" ::: "memory");
        bf16* Ow = T.O + (qrow0 + qb * 32) * DM + head * SHD; char* stg = lds + OST_OFF + wid * 4096;
#pragma unroll
        for (int r = 0; r < 16; ++r) { const int orow = crow(r, hi); const float rl = __builtin_amdgcn_rcpf(wsf[orow]);
#pragma unroll
            for (int d0 = 0; d0 < 2; ++d0) *(bf16*)(stg + orow * 128 + (d0 * 32 + r32) * 2) = (bf16)(cvtpk(o[d0][r] * rl, 0.f) & 0xffffu); }
        asm volatile("s_waitcnt lgkmcnt(0)" ::: "memory");
#pragma unroll
        for (int i = 0; i < 4; ++i) { const unsigned row = i * 8 + (lane >> 3); const v4u v = *(const v4u*)(stg + row * 128 + (lane & 7) * 16);
            *(v4u*)(Ow + (size_t)row * DM + (lane & 7) * 8) = v; }
        asm volatile("s_waitcnt lgkmcnt(0)" ::: "memory");
    }
    __syncthreads();
}
#undef SWA_PK4
#undef SWA_TRRD
__device__ __forceinline__ void swa_phase(char* lds, const Tensors& T, int vcu, int G) {
    constexpr int TOTAL = NB * (SEQ / 64) * SKV + DECB * SKV;
    for (int u = vcu; u < TOTAL; u += G) swa_unit(u, T, lds);
}
}

namespace sk {
constexpr int ROWB = 272;
constexpr int PART = 64 * ROWB;
constexpr int LDS_BYTES = 131072;
template <bool T> __device__ __forceinline__ size_t op_off(int row, int k, int K) { return T ? tiled_off(row, k, K) : ((size_t)row * K + k) * 2; }
template <int CB, bool AT, bool BT, class Epi>
__device__ __forceinline__ void sk_tile(const bf16* A, const bf16* Bt, int K, char* lds, const Epi& E, int grow0, int brow, int gcol0) {
    static_assert(!BT, "the weight operand of the skinny tiles is row-major");
    constexpr int NB = 2 * CB, BROUNDS = 2 * CB;
    constexpr int SBUF = 65536, SB_OFF = 32768;
    const int tid = fresh_tid(), wid = __builtin_amdgcn_readfirstlane(tid >> 6), lane = tid & 63, fr = lane & 15, fq = lane >> 4;
    const int nst = K >> 8;
    int lrow[4], lch[4]; size_t aoff[4];
#pragma unroll
    for (int j = 0; j < 4; ++j) {
        if (AT) { const int bb = tid * 16 + ((grow0 & 64) ? 8192 : 0), st = bb >> 10, sb = bb & 1023, swz = sb ^ (((sb >> 9) & 1) << 5), R = (st >> 1) * 16 + (swz >> 6), C = (st & 1) * 32 + ((swz & 63) >> 1);
            lrow[j] = R & 63; lch[j] = j * 8 + (C >> 3); aoff[j] = ((size_t)(grow0 >> 7) * (K >> 6) + j) * 16384 + bb; }
        else { const int idx = j * 512 + tid; lrow[j] = idx >> 5; lch[j] = idx & 31; aoff[j] = ((size_t)(grow0 + lrow[j]) * K + lch[j] * 8) * 2; }
    }
    const int brow_l = tid >> 5, bch = tid & 31;
    const char* Ab = (const char*)A; const char* Bb = (const char*)Bt + ((size_t)(brow + brow_l) * K + bch * 8) * 2;
    f32x4 acc[4][NB];
#pragma unroll
    for (int m = 0; m < 4; ++m)
#pragma unroll
        for (int n = 0; n < NB; ++n) acc[m][n] = (f32x4){0.f, 0.f, 0.f, 0.f};
    bf16x8 ra0[4], rb0[BROUNDS], ra1[4], rb1[BROUNDS], ra2[4], rb2[BROUNDS];
#define SK_GLOAD(ra, rb, s) do { if ((s) < nst) { _Pragma("unroll") for (int j = 0; j < 4; ++j) ra[j] = *(const bf16x8*)(Ab + aoff[j] + (size_t)(s) * (AT ? 65536 : 512)); \
        _Pragma("unroll") for (int j = 0; j < BROUNDS; ++j) rb[j] = *(const bf16x8*)(Bb + (size_t)(16 * j) * K * 2 + (size_t)(s) * 512); } } while (0)
#define SK_LWRITE(ra, rb, s) do { if ((s) < nst) { _Pragma("unroll") for (int j = 0; j < 4; ++j) *(bf16x8*)(lds + ((s) & 1) * SBUF + lrow[j] * 512 + ((lch[j] ^ (lrow[j] & 15)) << 4)) = ra[j]; \
        _Pragma("unroll") for (int j = 0; j < BROUNDS; ++j) *(bf16x8*)(lds + ((s) & 1) * SBUF + SB_OFF + (16 * j + brow_l) * 512 + ((bch ^ (brow_l & 15)) << 4)) = rb[j]; } } while (0)
    const int fo = fr * 512 + (((4 * wid + fq) ^ fr) << 4);
#define SK_COMPUTE(s) do { if ((s) < nst) { const char* sa = lds + ((s) & 1) * SBUF + fo; bf16x8 af[4], bfr[NB]; \
        _Pragma("unroll") for (int m = 0; m < 4; ++m) af[m] = *(const bf16x8*)(sa + m * 8192); \
        _Pragma("unroll") for (int n = 0; n < NB; ++n) bfr[n] = *(const bf16x8*)(sa + SB_OFF + n * 8192); \
        _Pragma("unroll") for (int m = 0; m < 4; ++m) _Pragma("unroll") for (int n = 0; n < NB; ++n) acc[m][n] = __builtin_amdgcn_mfma_f32_16x16x32_bf16(bfr[n], af[m], acc[m][n], 0, 0, 0); } } while (0)
    SK_GLOAD(ra0, rb0, 0); SK_GLOAD(ra1, rb1, 1);
    SK_LWRITE(ra0, rb0, 0); __syncthreads();
    for (int s = 0; s < nst; s += 3) {
        SK_GLOAD(ra2, rb2, s + 2); SK_COMPUTE(s);     SK_LWRITE(ra1, rb1, s + 1); __syncthreads();
        SK_GLOAD(ra0, rb0, s + 3); SK_COMPUTE(s + 1); SK_LWRITE(ra2, rb2, s + 2); __syncthreads();
        SK_GLOAD(ra1, rb1, s + 4); SK_COMPUTE(s + 2); SK_LWRITE(ra0, rb0, s + 3); __syncthreads();
    }
#undef SK_GLOAD
#undef SK_LWRITE
#undef SK_COMPUTE
    char* pw = lds + (wid & 3) * PART;
#define SK_AT(m, n) (pw + (16 * (m) + fr) * ROWB + (16 * (n) + 4 * fq) * 4)
    if (wid >= 4) {
#pragma unroll
        for (int m = 0; m < 4; ++m)
#pragma unroll
            for (int n = 0; n < NB; ++n) *(f32x4*)SK_AT(m, n) = acc[m][n]; }
    __syncthreads();
    if (wid < 4) {
#pragma unroll
        for (int m = 0; m < 4; ++m)
#pragma unroll
            for (int n = 0; n < NB; ++n) acc[m][n] += *(const f32x4*)SK_AT(m, n); }
    __syncthreads();
    if (wid < 4) {
#pragma unroll
        for (int m = 0; m < 4; ++m)
#pragma unroll
            for (int n = 0; n < NB; ++n) *(f32x4*)SK_AT(m, n) = acc[m][n]; }
    __syncthreads();
#undef SK_AT
    { const int row = tid >> 3, cg = (tid & 7) * 4 * CB; f32x4 v[CB];
#pragma unroll
        for (int c = 0; c < CB; ++c) { v[c] = *(const f32x4*)(lds + row * ROWB + (cg + 4 * c) * 4);
#pragma unroll
            for (int p = 1; p < 4; ++p) v[c] += *(const f32x4*)(lds + p * PART + row * ROWB + (cg + 4 * c) * 4); }
        E(grow0 + row, gcol0 + cg, v); }
    __syncthreads();
}
template <int CB, bool AT, bool BT, class Epi>
__device__ __forceinline__ void sk_gemm(const bf16* A, int row0, int nrt, const bf16* Bt, int brow0, int nct, int K, char* lds, const Epi& E, int vcu, int G, int rot = 0) {
    for (int t = (vcu + G - rot % G) % G; t < nrt * nct; t += G) { const int rt = t % nrt, ct = t / nrt;
        sk_tile<CB, AT, BT, Epi>(A, Bt, K, lds, E, row0 + 64 * rt, brow0 + 32 * CB * ct, 32 * CB * ct); }
}
__device__ __forceinline__ v4u pack8(f32x4 a, f32x4 b) { return (v4u){cvtpk(a[0], a[1]), cvtpk(a[2], a[3]), cvtpk(b[0], b[1]), cvtpk(b[2], b[3])}; }
struct SkFoxIn {
    bf16 *Q, *K, *V, *KC, *VC; float* out;
    __device__ __forceinline__ void operator()(int row, int col, const f32x4 (&v)[2]) const {
        const int kind = col >> 11, c = col & 2047, rs = row - MP, b = rs >> 5, t = rs & 31; const v4u w = pack8(v[0], v[1]);
        if (kind == 0) { *(v4u*)(Q + (size_t)row * DM + c) = w; }
        else { bf16* T = kind == 1 ? K : V; bf16* C = kind == 1 ? KC : VC; float* o = out + (kind == 1 ? O_FKS : O_FVS) + (size_t)rs * DM + c;
            *(v4u*)(T + (size_t)row * DM + c) = w; *(v4u*)(C + ((size_t)b * KCROWS + PAST + t) * DM + c) = w; *(f32x4*)o = v[0]; *(f32x4*)(o + 4) = v[1]; }
    }
};
struct SkGates {
    float* out; const float* bfg; float* lfh;
    __device__ __forceinline__ void operator()(int row, int col, const f32x4 (&v)[1]) const {
        if (col < FH) { const f32x4 b4 = *(const f32x4*)(bfg + col); f32x4 o;
#pragma unroll
            for (int e = 0; e < 4; ++e) { const float z = v[0][e] + b4[e]; o[e] = fminf(z, 0.f) - log1pf(__expf(-fabsf(z))); }
            float* dst = row < MP ? out + O_FLP + (size_t)row * FH : out + O_FLS + (size_t)(row - MP) * FH;
            *(f32x4*)(dst + col) = o;
            if (row < MP) { float* lp = lfh + ((size_t)(row >> 14) * FH + col) * SEQ + (row & (SEQ - 1));
#pragma unroll
                for (int e = 0; e < 4; ++e) lp[(size_t)e * SEQ] = o[e]; } }
    }
};
template <bool FUSE> struct SkResid {
    const float* base; float* X; const float* gate;
    const float* ng; const float* nsc; bf16* H; float* rss;
    __device__ __forceinline__ void operator()(int row, int col, const f32x4 (&v)[2]) const {
        const int rs = row - MP, ar = 2 + (rs >> 5); const float* gp = gate + (size_t)ar * ADAW + col; const float* bp = base + (size_t)rs * DM + col; float* xp = X + (size_t)rs * DM + col;
        const f32x4 g0 = *(const f32x4*)gp, g1 = *(const f32x4*)(gp + 4), b0 = *(const f32x4*)bp, b1 = *(const f32x4*)(bp + 4);
        const f32x4 x0 = b0 + g0 * v[0], x1 = b1 + g1 * v[1];
        *(f32x4*)xp = x0; *(f32x4*)(xp + 4) = x1;
        if (FUSE) { const float* sp = nsc + (size_t)ar * ADAW + col;
            const f32x4 c0 = *(const f32x4*)(ng + col) * (*(const f32x4*)sp + 1.0f), c1 = *(const f32x4*)(ng + col + 4) * (*(const f32x4*)(sp + 4) + 1.0f);
            *(v4u*)((char*)H + tiled_off(row, col, DM)) = pack8(x0 * c0, x1 * c1);
            float ss = ((x0[0] * x0[0] + x0[1] * x0[1]) + (x0[2] * x0[2] + x0[3] * x0[3])) + ((x1[0] * x1[0] + x1[1] * x1[1]) + (x1[2] * x1[2] + x1[3] * x1[3]));
            ss += __shfl_xor(ss, 1); ss += __shfl_xor(ss, 2); ss += __shfl_xor(ss, 4);
            if ((col & 63) == 0) (void)__hip_atomic_fetch_add(rss + row, ss, __ATOMIC_RELAXED, __HIP_MEMORY_SCOPE_AGENT); }
    }
};
struct SkUp {
    bf16* Ah; const float* rss; const float* sw;
    __device__ __forceinline__ void operator()(int row, int col, const f32x4 (&v)[2]) const {
        const float rstd = 1.0f / sqrtf(rss[row] * (1.0f / DM) + RMS_EPS); const float* swp = sw + (size_t)(2 + ((row - MP) >> 5)) * DFF + col;
        f32x4 a = v[0] * rstd + *(const f32x4*)swp, b = v[1] * rstd + *(const f32x4*)(swp + 4);
#pragma unroll
        for (int e = 0; e < 4; ++e) { const float x = fmaxf(a[e], 0.f), y = fmaxf(b[e], 0.f); a[e] = x * x; b[e] = y * y; }
        *(v4u*)((char*)Ah + tiled_off(row, col, DFF)) = pack8(a, b);
    }
};
struct SkSW {
    float* SW; int N;
    __device__ __forceinline__ void operator()(int row, int col, const f32x4 (&v)[2]) const {
        if (row < NADA) { float* o = SW + (size_t)row * N + col; *(f32x4*)o = v[0]; *(f32x4*)(o + 4) = v[1]; }
    }
};
struct SkSwaIn {
    bf16 *Q, *K, *V, *KSC, *VSC; float* out; const float* rope; const float* rss; const float* sw;
    __device__ __forceinline__ void operator()(int row, int col, const f32x4 (&vin)[2]) const {
        const int kind = col < DM ? 0 : (col < DM + 256 ? 1 : 2), rs = row - MP, b = rs >> 5, t = rs & 31;
        const float rstd = 1.0f / sqrtf(rss[row] * (1.0f / DM) + RMS_EPS); const float* swp = sw + (size_t)(2 + b) * SWA_IN + col;
        f32x4 v0 = vin[0] * rstd + *(const f32x4*)swp, v1 = vin[1] * rstd + *(const f32x4*)(swp + 4);
        { f32x4 p0, p1;
#pragma unroll
            for (int e = 0; e < 4; ++e) { p0[e] = __shfl_xor(v0[e], 1); p1[e] = __shfl_xor(v1[e], 1); }
            if (kind != 2 && (col & 63) < 16) { const float* rp = rope + (size_t)(PAST + t) * 16;
                const f32x4 c0 = *(const f32x4*)rp, c1 = *(const f32x4*)(rp + 4), s0 = *(const f32x4*)(rp + 8), s1 = *(const f32x4*)(rp + 12);
                if ((col & 8) == 0) { v0 = v0 * c0 - p0 * s0; v1 = v1 * c1 - p1 * s1; } else { v0 = v0 * c0 + p0 * s0; v1 = v1 * c1 + p1 * s1; } } }
        const v4u w = pack8(v0, v1);
        if (kind == 0) { *(v4u*)(Q + (size_t)row * DM + col) = w; }
        else { const int c = (col - DM) & 255; bf16* T = kind == 1 ? K : V; bf16* C = kind == 1 ? KSC : VSC; float* o = out + (kind == 1 ? O_SKS : O_SVS) + ((size_t)b * WBUF + (WBUF - DECT) + t) * 256 + c;
            *(v4u*)(T + (size_t)row * 256 + c) = w; *(v4u*)(C + ((size_t)b * SROWS + WBUF + t) * 256 + c) = w; *(f32x4*)o = v0; *(f32x4*)(o + 4) = v1; }
    }
};
}
#define XB_TMO      128
#define XB_XCNT(j)  (256  + 64 * (j))
#define XB_XSUB(j)  (1280 + 64 * (j))
#define XB_XGEN(j)  (2304 + 64 * (j))
#define XB_TOP      3328
#define XB_TOPGEN   3392
#define XCD_BAR_WORDS 3456
#define XB_SPIN_CAP (1u << 18)

__device__ __forceinline__ unsigned xb_ld(unsigned* p)              { return __hip_atomic_load(p, __ATOMIC_RELAXED, __HIP_MEMORY_SCOPE_AGENT); }
__device__ __forceinline__ unsigned xb_add(unsigned* p, unsigned v) { return __hip_atomic_fetch_add(p, v, __ATOMIC_RELAXED, __HIP_MEMORY_SCOPE_AGENT); }
__device__ __forceinline__ unsigned xb_xcc_id() { return (unsigned)__builtin_amdgcn_s_getreg((3 << 11) | 20) & 0xFu; }
#define XB_SPIN(cond, bar) do { unsigned _sp = 0; while (cond) { __builtin_amdgcn_s_sleep(1); \
    if ((++_sp & 255u) == 0u) { if (xb_ld(&(bar)[XB_TMO])) break; if (_sp > XB_SPIN_CAP) { atomicAdd(&(bar)[XB_TMO], 1u); break; } } } } while (0)

struct XcdBarrier {
    unsigned* bar; unsigned x;
    volatile LAS unsigned* st;
};

__device__ __forceinline__ XcdBarrier xcd_barrier_post(unsigned* bar, volatile LAS unsigned* st) {
    XcdBarrier b; b.bar = bar; b.x = xb_xcc_id(); b.st = st;
    if (threadIdx.x == 0) (void)xb_add(&bar[XB_XCNT(b.x)], 1u);
    return b;
}
__device__ __forceinline__ void xcd_barrier_complete(unsigned* bar, unsigned x, unsigned& nloc, unsigned& nx) {
    const unsigned G = gridDim.x * gridDim.y * gridDim.z;
    unsigned sum, cnt, mine, sp = 0u;
    for (;;) {
        sum = 0u; cnt = 0u; mine = 0u;
#pragma unroll
        for (unsigned j = 0; j < 16; ++j) { const unsigned c = xb_ld(&bar[XB_XCNT(j)]); sum += c; cnt += (c > 0u) ? 1u : 0u; mine = (j == x) ? c : mine; }
        if (sum == G) break;
        __builtin_amdgcn_s_sleep(1);
        if ((++sp & 255u) == 0u) { if (xb_ld(&bar[XB_TMO])) break; if (sp > XB_SPIN_CAP) { atomicAdd(&bar[XB_TMO], 1u); break; } }
    }
    nloc = mine > 0u ? mine : 1u; nx = cnt > 0u ? cnt : 1u;
}

__device__ __forceinline__ void xcd_barrier(const XcdBarrier& b) {
    asm volatile("s_waitcnt vmcnt(0)" ::: "memory");
    __syncthreads();
    if (threadIdx.x == 0) {
        unsigned* bar = b.bar;
        __builtin_amdgcn_s_waitcnt(0);
        unsigned nloc = b.st[0], nx = b.st[1];
        if (nloc == 0u) { xcd_barrier_complete(bar, b.x, nloc, nx); b.st[0] = nloc; b.st[1] = nx; }
        const unsigned old = xb_add(&bar[XB_XSUB(b.x)], 1u);
        const unsigned gen = old / nloc;
        if (old + 1u == (gen + 1u) * nloc) {
            __builtin_amdgcn_fence(__ATOMIC_RELEASE, "agent");
            asm volatile("s_waitcnt vmcnt(0)" ::: "memory");
            const unsigned og = xb_add(&bar[XB_TOP], 1u);
            const unsigned tg = og / nx;
            if (og + 1u == (tg + 1u) * nx) xb_add(&bar[XB_TOPGEN], 1u);
            else XB_SPIN(xb_ld(&bar[XB_TOPGEN]) == tg, bar);
            __builtin_amdgcn_fence(__ATOMIC_ACQUIRE, "agent");
            xb_add(&bar[XB_XGEN(b.x)], 1u);
            asm volatile("s_waitcnt vmcnt(0)" ::: "memory");
        } else {
            XB_SPIN(xb_ld(&bar[XB_XGEN(b.x)]) == gen, bar);
            __builtin_amdgcn_fence(__ATOMIC_ACQUIRE, "agent");
            asm volatile("s_waitcnt vmcnt(0)" ::: "memory");
        }
    }
    __syncthreads();
}

constexpr int NWAVES = 8;
constexpr int RING_OFF = 0, RING_BYTES = 131072, LDSCTL_OFF = RING_BYTES, MISC_OFF = LDSCTL_OFF + 320, LDS_BYTES = 147456;
static_assert(fox::LDS_BYTES <= RING_BYTES && swa::LDS_BYTES <= RING_BYTES && MISC_OFF + 128 <= LDS_BYTES, "LDS map");

struct Args { const float* in[22]; float* out; unsigned char* ws; int ph_lo, ph_hi, li, pad; };
struct Frame { int tid, lane, wave, vcu, G; };
typedef const __attribute__((address_space(4))) Args* KA;
__device__ __forceinline__ KA fresh_args() { KA p = (KA)__builtin_amdgcn_kernarg_segment_ptr(); asm volatile("" : "+s"(p)); return p; }

__device__ __forceinline__ float wave_sum(float v) {
#pragma unroll
    for (int o = 1; o < 64; o <<= 1) v += __shfl_xor(v, o);
    return v;
}

__device__ __forceinline__ void p0_transpose_item(const float* W, int K, int ldw, int nvalid, int nblk, bf16* WT, LAS float* scr, int item, int lane) {
    const int kb = item / nblk, nb = item % nblk, k0 = 64 * kb, n0 = 32 * nb;
    const int ncol = n0 + (lane & 31); const bool ok = ncol < nvalid;
    const float* wp = W + (size_t)(k0 + (lane >> 5)) * ldw + (ok ? ncol : 0);
#pragma unroll
    for (int h = 0; h < 2; ++h) {
        float t[16];
#pragma unroll
        for (int i = 0; i < 16; ++i) t[i] = wp[(size_t)(2 * (16 * h + i)) * ldw];
#pragma unroll
        for (int i = 0; i < 16; ++i) scr[(2 * (16 * h + i) + (lane >> 5)) * 33 + (lane & 31)] = ok ? t[i] : 0.f;
    }
    LDS_WAIT(); asm volatile("" ::: "memory");
    const int c = lane & 7;
#pragma unroll
    for (int j = 0; j < 4; ++j) { const int n = (lane >> 3) + 8 * j; const LAS float* s = scr + (8 * c) * 33 + n;
        v4u o; o.x = cvtpk(s[0 * 33], s[1 * 33]); o.y = cvtpk(s[2 * 33], s[3 * 33]); o.z = cvtpk(s[4 * 33], s[5 * 33]); o.w = cvtpk(s[6 * 33], s[7 * 33]);
        *(GAS v4u*)(WT + (size_t)(n0 + n) * K + k0 + 8 * c) = o; }
    LDS_WAIT(); asm volatile("" ::: "memory");
}
__device__ __forceinline__ void cvt_row_bf16(const float* src, bf16* dst, int lane) {
    const GAS f32x4* xr = (const GAS f32x4*)src + lane; GAS v2u* o8 = (GAS v2u*)dst + lane;
    f32x4 v[8];
#pragma unroll
    for (int j = 0; j < 8; ++j) v[j] = xr[64 * j];
#pragma unroll
    for (int j = 0; j < 8; ++j) { v2u w; w.x = cvtpk(v[j][0], v[j][1]); w.y = cvtpk(v[j][2], v[j][3]); o8[64 * j] = w; }
}
__device__ __forceinline__ void sincos_d(double a, double& s, double& c) {
    const double n = __builtin_rint(a * 0.6366197723675814);
    double r = __builtin_fma(-n, 1.5707963267948966, a); r = __builtin_fma(-n, 6.123233995736766e-17, r);
    const double r2 = r * r;
    double ps = -7.6471637318198164759e-13; ps = ps * r2 + 1.6059043836821614599e-10; ps = ps * r2 - 2.5052108385441718775e-8; ps = ps * r2 + 2.7557319223985890653e-6;
    ps = ps * r2 - 1.9841269841269841270e-4; ps = ps * r2 + 8.3333333333333333333e-3; ps = ps * r2 - 1.6666666666666666667e-1; ps = r + r * r2 * ps;
    double pc = 4.7794773323873852974e-14; pc = pc * r2 - 1.1470745597729724714e-11; pc = pc * r2 + 2.0876756987868098979e-9; pc = pc * r2 - 2.7557319223985890653e-7;
    pc = pc * r2 + 2.4801587301587301587e-5; pc = pc * r2 - 1.3888888888888888889e-3; pc = pc * r2 + 4.1666666666666666667e-2; pc = pc * r2 - 0.5; pc = 1.0 + r2 * pc;
    const int q = (int)n & 3;
    s = (q == 0) ? ps : (q == 1) ? pc : (q == 2) ? -ps : -pc;
    c = (q == 0) ? pc : (q == 1) ? -ps : (q == 2) ? -pc : ps;
}

__device__ __forceinline__ void p0_ada(KA a, const Frame& F, LAS unsigned char* lds) {
    LAS float* sS = (LAS float*)lds;
    LAS float* red = (LAS float*)(lds + 36864);
    const float* cP = a->in[2]; const float* cS = a->in[3]; const float* W = a->in[9]; const float* Bv = a->in[10];
    float* ADA = (float*)(a->ws + WS_ADA);
    const int half = F.lane >> 5, cl = (F.lane & 31) * 4;
    for (int task = F.vcu; task < 2 * (ADAW / 128); task += F.G) {
        const int l = task / (ADAW / 128), n0 = (task % (ADAW / 128)) * 128;
        const float* Wl = W + (size_t)l * DM * ADAW + n0 + cl;
        f32x4 acc[NADA];
#pragma unroll
        for (int r = 0; r < NADA; ++r) acc[r] = (f32x4){0.f, 0.f, 0.f, 0.f};
        for (int stage = 0; stage < 4; ++stage) {
            __syncthreads();
            for (int idx = F.tid; idx < NADA * 512; idx += NWAVES * 64) { const int r = idx >> 9, k = idx & 511;
                const float cv = r < 2 ? cP[r * DM + stage * 512 + k] : cS[(r - 2) * DM + stage * 512 + k];
                sS[idx] = cv / (1.f + __expf(-cv)); }
            __syncthreads();
            const int kw = F.wave * 64;
#pragma unroll 1
            for (int i0 = 0; i0 < 32; i0 += 8) {
                f32x4 wv[8];
#pragma unroll
                for (int i = 0; i < 8; ++i) wv[i] = *(const f32x4*)(Wl + (size_t)(stage * 512 + kw + 2 * (i0 + i) + half) * ADAW);
#pragma unroll
                for (int i = 0; i < 8; ++i) { const int k = kw + 2 * (i0 + i) + half;
#pragma unroll
                    for (int r = 0; r < NADA; ++r) acc[r] += wv[i] * sS[r * 512 + k]; }
            }
        }
#pragma unroll
        for (int hh = 0; hh < 2; ++hh) {
            __syncthreads();
#pragma unroll
            for (int r = 0; r < 9; ++r) *(LAS f32x4*)(red + ((F.wave * 2 + half) * 9 + r) * 128 + cl) = acc[9 * hh + r];
            __syncthreads();
            for (int idx = F.tid; idx < 9 * 128; idx += NWAVES * 64) { const int r = idx >> 7, c = idx & 127; float s = 0.f;
#pragma unroll
                for (int p = 0; p < 16; ++p) s += red[(p * 9 + r) * 128 + c];
                ADA[((size_t)l * NADA + 9 * hh + r) * ADAW + n0 + c] = s + Bv[(size_t)l * ADAW + n0 + c]; }
        }
    }
    __syncthreads();
}

constexpr int I_FIN = 32 * (FOX_IN_PAD / 32), I_SQ = 32 * 64, I_SIN = 32 * (SWA_IN / 32), I_UP = 32 * (DFF / 32), I_DN = (DFF / 64) * 64;
constexpr int NITEMS = I_FIN + 2 * I_SQ + I_SIN + 2 * I_UP + 2 * I_DN;
__device__ __forceinline__ void p0_copies(KA a, LAS unsigned char* lds, int wave, int lane, int first, int it0, int it1, int gw, int NGW, bool caches) {
    unsigned char* ws = a->ws;
    LAS float* scr = (LAS float*)(lds + wave * 16384);
    for (int it = it0 + first; it < it1; it += NGW) {
        int r = it;
        if (r < I_FIN) { p0_transpose_item(a->in[13], DM, FOX_IN, FOX_IN, FOX_IN_PAD / 32, (bf16*)(ws + WS_WFIN), scr, r, lane); continue; } r -= I_FIN;
        if (r < I_SQ) { p0_transpose_item(a->in[15], DM, DM, DM, 64, (bf16*)(ws + WS_WFOUT), scr, r, lane); continue; } r -= I_SQ;
        if (r < I_SIN) { p0_transpose_item(a->in[16], DM, SWA_IN, SWA_IN, SWA_IN / 32, (bf16*)(ws + WS_WSIN), scr, r, lane); continue; } r -= I_SIN;
        if (r < I_SQ) { p0_transpose_item(a->in[18], DM, DM, DM, 64, (bf16*)(ws + WS_WSOUT), scr, r, lane); continue; } r -= I_SQ;
        if (r < 2 * I_UP) { const int l = r / I_UP; p0_transpose_item(a->in[19] + (size_t)l * DM * DFF, DM, DFF, DFF, DFF / 32, (bf16*)(ws + WS_WUP) + (size_t)l * DM * DFF, scr, r % I_UP, lane); continue; } r -= 2 * I_UP;
        { const int l = r / I_DN; p0_transpose_item(a->in[20] + (size_t)l * DM * DFF, DFF, DM, DM, 64, (bf16*)(ws + WS_WDN) + (size_t)l * DM * DFF, scr, r % I_DN, lane); }
    }
    if (caches) for (int it = gw; it < 2 * DECB * KCROWS; it += NGW) {
        const int kv = it / (DECB * KCROWS), rem = it % (DECB * KCROWS), b = rem / KCROWS, p = rem % KCROWS;
        bf16* dst = (bf16*)(ws + (kv ? WS_VC : WS_KC)) + ((size_t)b * KCROWS + p) * DM;
        if (p < PAST) cvt_row_bf16(a->in[kv ? 5 : 4] + ((size_t)b * PAST + p) * DM, dst, lane);
        else if (p >= PAST + DECT) { GAS v2u* o8 = (GAS v2u*)dst + lane;
#pragma unroll
            for (int j = 0; j < 8; ++j) o8[64 * j] = (v2u){0u, 0u}; }
    }
}
constexpr int NWORK = 4;
__device__ __forceinline__ void p0_prologue(KA a, const Frame& F, LAS unsigned char* lds) {
    unsigned char* ws = a->ws;
    p0_ada(a, F, lds);
    const int gw = F.vcu * NWAVES + F.wave, NGW = F.G * NWAVES;
    const int irot = NGW > 2 * (ADAW / 128) * NWAVES ? 2 * (ADAW / 128) * NWAVES : 0;
    const bool split = (F.G % 8 == 0) && (F.G / 8 > NWORK);
    p0_copies(a, lds, F.wave, F.lane, (gw + NGW - irot) % NGW, 0, split ? I_FIN : NITEMS, gw, NGW, !split);
    const int gt = (F.vcu * NWAVES + F.wave) * 64 + F.lane, NGT = NGW * 64;
    float* rope = (float*)(ws + WS_ROPE);
    for (int e = gt; e < SEQ * 8; e += NGT) { const int pos = e >> 3, i = e & 7;
        const double inv = i == 0 ? 1.0 : i == 1 ? 0.19392274474868576 : i == 2 ? 0.03760603093086393 : i == 3 ? 0.007292664737217109 : i == 4 ? 0.001414213562373095 :
                           i == 5 ? 0.0002742481756762073 : i == 6 ? 5.318295896944988e-05 : 1.031338537721246e-05;
        double s, c; sincos_d((double)pos * inv, s, c); rope[pos * 16 + i] = (float)c; rope[pos * 16 + 8 + i] = (float)s; }
    for (int e = gt; e < 2 * DECB * WBUF * 256; e += NGT) { const int kv = e / (DECB * WBUF * 256), rem = e % (DECB * WBUF * 256), b = rem / (WBUF * 256), p = (rem / 256) % WBUF, c = rem & 255;
        const float v = a->in[kv ? 8 : 7][rem];
        ((bf16*)(ws + (kv ? WS_VSC : WS_KSC)))[((size_t)b * SROWS + p) * 256 + c] = (bf16)(cvtpk(v, 0.f) & 0xffffu);
        if (p >= DECT) a->out[(kv ? O_SVS : O_SKS) + ((size_t)b * WBUF + (p - DECT)) * 256 + c] = v; }
}

__device__ __forceinline__ void norm_rows(const float* xP, const float* xS, const float* g, const float* ada_l, int shift_idx, bf16* H, const Frame& F) {
    const int gw = F.vcu * NWAVES + F.wave, NGW = F.G * NWAVES;
    for (int blk = gw; blk < MP / 16 + MS; blk += NGW) {
        const int row0 = blk < MP / 16 ? blk * 16 : MP + (blk - MP / 16), nrows = blk < MP / 16 ? 16 : 1;
        const float* ap = ada_l + (size_t)arow_of(row0) * ADAW + shift_idx * DM;
        f32x4 mul[8], add[8];
#pragma unroll
        for (int j = 0; j < 8; ++j) { const int c = 4 * F.lane + 256 * j; const f32x4 gv = *(const f32x4*)(g + c), sc = *(const f32x4*)(ap + DM + c); add[j] = *(const f32x4*)(ap + c); mul[j] = gv * (sc + 1.0f); }
        for (int rr = 0; rr < nrows; ++rr) { const int row = row0 + rr;
            const GAS f32x4* xr = (const GAS f32x4*)(row < MP ? xP + (size_t)row * DM : xS + (size_t)(row - MP) * DM) + F.lane;
            f32x4 v[8]; float ss = 0.f;
#pragma unroll
            for (int j = 0; j < 8; ++j) { v[j] = xr[64 * j]; ss += (v[j][0] * v[j][0] + v[j][1] * v[j][1]) + (v[j][2] * v[j][2] + v[j][3] * v[j][3]); }
            const float rstd = 1.0f / sqrtf(wave_sum(ss) * (1.0f / DM) + RMS_EPS);
            const size_t o0 = tiled_off(row, 4 * F.lane, DM);
#pragma unroll
            for (int j = 0; j < 8; ++j) { const f32x4 h = (v[j] * rstd) * mul[j] + add[j]; v2u w; w.x = cvtpk(h[0], h[1]); w.y = cvtpk(h[2], h[3]); *(GAS v2u*)((GAS char*)H + o0 + (size_t)j * 65536) = w; }
        }
    }
}
__device__ __forceinline__ void fill_shift_rows(const float* ADA, bf16* SH, const Frame& F) {
    const int gt = (F.vcu * NWAVES + F.wave) * 64 + F.lane, NGT = F.G * NWAVES * 64;
    for (int e = gt; e < 3 * 64 * DM; e += NGT) { const int c = e / (64 * DM), r = (e / DM) & 63, k = e & (DM - 1);
        const float* sh = ADA + (c == 0 ? 3 * DM : (c == 1 ? NADA * ADAW : NADA * ADAW + 3 * DM));
        SH[e] = r < NADA ? (bf16)(cvtpk(sh[(size_t)r * ADAW + k], 0.f) & 0xffffu) : (bf16)0; }
}
__device__ __forceinline__ void final_norm(float* X, const float* g, const Frame& F) {
    const int gw = F.vcu * NWAVES + F.wave, NGW = F.G * NWAVES;
    f32x4 gv[8];
#pragma unroll
    for (int j = 0; j < 8; ++j) gv[j] = *(const f32x4*)(g + 4 * F.lane + 256 * j);
    for (int row = gw; row < MT; row += NGW) {
        GAS f32x4* xr = (GAS f32x4*)(X + (size_t)row * DM) + F.lane;
        f32x4 v[8]; float ss = 0.f;
#pragma unroll
        for (int j = 0; j < 8; ++j) { v[j] = xr[64 * j]; ss += (v[j][0] * v[j][0] + v[j][1] * v[j][1]) + (v[j][2] * v[j][2] + v[j][3] * v[j][3]); }
        const float rstd = 1.0f / sqrtf(wave_sum(ss) * (1.0f / DM) + RMS_EPS);
#pragma unroll
        for (int j = 0; j < 8; ++j) xr[64 * j] = (v[j] * rstd) * gv[j];
    }
}
__device__ __forceinline__ void bias_rows(float x, bf16* ck, bf16* cq) {
    const unsigned c1 = cvtpk(x, 0.f) & 0xffffu; const float r1 = x - __uint_as_float(c1 << 16);
    const unsigned c2 = cvtpk(r1, 0.f) & 0xffffu; const float r2 = r1 - __uint_as_float(c2 << 16);
    const unsigned c3 = cvtpk(r2, 0.f) & 0xffffu;
    const unsigned one = 0x3F80u;
    *(GAS v4u*)ck = (v4u){(c1 ^ 0x8000u) | ((c2 ^ 0x8000u) << 16), (c3 ^ 0x8000u) | (one << 16), one | (one << 16), 0u};
    *(GAS v4u*)cq = (v4u){one | (one << 16), one | (c1 << 16), c2 | (c3 << 16), 0u};
}
__device__ __forceinline__ void fox_norms(const bf16* Q, const bf16* K, float* QN, float* KN, float* SD, const Frame& F) {
    const int gw = F.vcu * NWAVES + F.wave, NGW = F.G * NWAVES;
    for (int row = gw; row < MP; row += NGW) {
        const GAS v4u* qp = (const GAS v4u*)(Q + (size_t)row * DM) + 4 * F.lane; const GAS v4u* kp = (const GAS v4u*)(K + (size_t)row * DM) + 4 * F.lane;
        v4u qv[4], kv[4];
#pragma unroll
        for (int j = 0; j < 4; ++j) { qv[j] = qp[j]; kv[j] = kp[j]; }
        float qq = 0.f, kk = 0.f, qk = 0.f;
#pragma unroll
        for (int j = 0; j < 4; ++j)
#pragma unroll
            for (int e = 0; e < 4; ++e) { const float q0 = __uint_as_float(qv[j][e] << 16), q1 = __uint_as_float(qv[j][e] & 0xffff0000u), k0 = __uint_as_float(kv[j][e] << 16), k1 = __uint_as_float(kv[j][e] & 0xffff0000u);
                qq += q0 * q0 + q1 * q1; kk += k0 * k0 + k1 * k1; qk += q0 * k0 + q1 * k1; }
        qq += __shfl_xor(qq, 1); kk += __shfl_xor(kk, 1); qk += __shfl_xor(qk, 1);
        qq += __shfl_xor(qq, 2); kk += __shfl_xor(kk, 2); qk += __shfl_xor(qk, 2);
        if ((F.lane & 3) == 0) { const size_t ix = ((size_t)(row >> 14) * FH + (F.lane >> 2)) * SEQ + (row & (SEQ - 1)); QN[ix] = qq; KN[ix] = kk; SD[ix] = qk * 0.08838834764831845f; }
    }
}
constexpr float PRUNE_EPS = 2.9802322e-8f;
__device__ __forceinline__ void fox_scan(KA a, const Frame& F, LAS unsigned char* lds) {
    LAS double* sd = (LAS double*)lds;
    LAS float* s_cend = (LAS float*)(lds + 8192);
    LAS float* s_kpre = (LAS float*)(lds + 10240);
    LAS float* s_qmax = (LAS float*)(lds + 14336);
    LAS float* s_sdmin = (LAS float*)(lds + 16384);
    LAS float* stg = (LAS float*)(lds + 20480);
    const float* QN = (const float*)(a->ws + WS_QN); const float* KN = (const float*)(a->ws + WS_KN); const float* SD = (const float*)(a->ws + WS_SD); const float* LFH = (const float*)(a->ws + WS_LFH);
    int* JLO = (int*)(a->ws + WS_JLO);
    const float* lsm = a->out + O_FLS; const float* lc = a->in[6];
    const int tid = F.tid;
    for (int task = F.vcu; task < NB * FH + DECB * FH; task += F.G) {
        if (task < NB * FH) {
            const int s = task; const size_t sb = (size_t)s * SEQ;
            bf16* dk = (bf16*)(a->ws + WS_CKP) + sb * 8; bf16* dq = (bf16*)(a->ws + WS_CQP) + sb * 8;
#define SCAN_STAGE(SRC) do { __syncthreads(); f32x4 t_[8]; _Pragma("unroll") for (int k = 0; k < 8; ++k) t_[k] = *(const f32x4*)((SRC) + sb + (size_t)(k * 512 + tid) * 4); \
            _Pragma("unroll") for (int k = 0; k < 8; ++k) { const int p = (k * 512 + tid) * 4, q_ = p + (p >> 5); stg[q_] = t_[k][0]; stg[q_ + 1] = t_[k][1]; stg[q_ + 2] = t_[k][2]; stg[q_ + 3] = t_[k][3]; } __syncthreads(); } while (0)
            float kmx = 0.f, qmx = 0.f, sdm = 3.0e38f; double loc = 0.0;
            SCAN_STAGE(KN);
#pragma unroll 8
            for (int i = 0; i < 32; ++i) kmx = fmaxf(kmx, stg[33 * tid + i]);
            SCAN_STAGE(QN);
#pragma unroll 8
            for (int i = 0; i < 32; ++i) qmx = fmaxf(qmx, stg[33 * tid + i]);
            SCAN_STAGE(SD);
#pragma unroll 8
            for (int i = 0; i < 32; ++i) sdm = fminf(sdm, stg[33 * tid + i]);
            SCAN_STAGE(LFH);
#pragma unroll 8
            for (int i = 0; i < 32; ++i) loc += (double)stg[33 * tid + i];
#undef SCAN_STAGE
            sd[tid] = loc; __syncthreads();
            int cur = 0;
            for (int off = 1; off < 512; off <<= 1) { const double v = sd[cur * 512 + tid] + (tid >= off ? sd[cur * 512 + tid - off] : 0.0); sd[(cur ^ 1) * 512 + tid] = v; cur ^= 1; __syncthreads(); }
            double run = sd[cur * 512 + tid] - loc;
#pragma unroll 8
            for (int i = 0; i < 32; ++i) { run += (double)stg[33 * tid + i]; stg[33 * tid + i] = (float)(run * 11.313708498984761); }
            s_cend[tid] = (float)run; s_qmax[tid] = qmx; s_sdmin[tid] = sdm; s_kpre[tid] = kmx; __syncthreads();
            for (int k = 0; k < 32; ++k) { const int p = k * 512 + tid; bias_rows(stg[p + (p >> 5)], dk + (size_t)p * 8, dq + (size_t)p * 8); }
            if (tid < SEQ / 256) { const int qb = tid; int jlo = 0;
                if (qb > 0) { float q2 = 0.f, ml = 3.0e38f;
                    for (int i = 0; i < 8; ++i) { q2 = fmaxf(q2, s_qmax[8 * qb + i]); ml = fminf(ml, s_sdmin[8 * qb + i]); }
                    const float cq = s_cend[8 * qb - 1]; float S = 0.f;
                    for (int j = 0; j < 4 * qb; ++j) { const float U = 1.001f * 0.08838834764831845f * sqrtf(q2 * fmaxf(s_kpre[2 * j], s_kpre[2 * j + 1])) + (cq - s_cend[2 * j + 1]);
                        S += 64.64f * __expf(fminf(U - ml, 0.f));
                        if (S > PRUNE_EPS) break;
                        jlo = j + 1; } }
                JLO[s * (SEQ / 256) + qb] = jlo; }
        } else {
            const int s = task - NB * FH, b = s >> 4, h = s & 15; constexpr int L = PAST + DECT, per = 3;
            bf16* dk = (bf16*)(a->ws + WS_CKS) + (size_t)s * KCROWS * 8; bf16* dq = (bf16*)(a->ws + WS_CQS) + (size_t)s * KCROWS * 8;
            const int p0 = tid * per, p1 = (p0 + per < L) ? p0 + per : L;
            double loc = 0.0;
            for (int p = p0; p < p1; ++p) { const float v = p < PAST ? lc[((size_t)b * PAST + p) * FH + h] : lsm[((size_t)b * DECT + (p - PAST)) * FH + h]; loc += (double)v; }
            __syncthreads();
            sd[tid] = loc; __syncthreads();
            int cur = 0;
            for (int off = 1; off < 512; off <<= 1) { const double v = sd[cur * 512 + tid] + (tid >= off ? sd[cur * 512 + tid - off] : 0.0); sd[(cur ^ 1) * 512 + tid] = v; cur ^= 1; __syncthreads(); }
            double run = sd[cur * 512 + tid] - loc;
            for (int p = p0; p < p1; ++p) { const float v = p < PAST ? lc[((size_t)b * PAST + p) * FH + h] : lsm[((size_t)b * DECT + (p - PAST)) * FH + h]; run += (double)v;
                bias_rows((float)(run * 11.313708498984761), dk + (size_t)p * 8, dq + (size_t)p * 8); }
            const double tot = sd[cur * 512 + 511]; if (tid < KCROWS - (PAST + DECT)) bias_rows((float)(tot * 11.313708498984761), dk + (size_t)(PAST + DECT + tid) * 8, dq + (size_t)(PAST + DECT + tid) * 8);
        }
    }
    __syncthreads();
}

#ifndef MK_N_LAUNCHES
#define MK_N_LAUNCHES 1
#endif
constexpr int N_PHASES = 18;
constexpr bool ONE_LAUNCH = (MK_N_LAUNCHES == 1);

__global__ void __launch_bounds__(NWAVES * 64, 2) mk_fwd(Args args) {
    extern __shared__ __attribute__((aligned(16))) unsigned char lds[];
    LAS unsigned char* ldsl = (LAS unsigned char*)lds;
    volatile LAS unsigned* MISC = (volatile LAS unsigned*)(ldsl + MISC_OFF);
    gu32* ctl = (gu32*)(args.ws + WS_CTL);
    for (int u = fresh_tid(); u < (LDS_BYTES - LDSCTL_OFF) / 4; u += NWAVES * 64) ((LAS unsigned*)(ldsl + LDSCTL_OFF))[u] = 0u;
    __syncthreads();
    XcdBarrier bar; bar.bar = (unsigned*)(ctl + CW_BAR); bar.x = 0; bar.st = nullptr;
    if (ONE_LAUNCH) bar = xcd_barrier_post((unsigned*)(ctl + CW_BAR), MISC + 8);
#define GRID_BAR() do { if (ONE_LAUNCH) xcd_barrier(bar); } while (0)
    const int lo = args.ph_lo, hi = args.ph_hi;
#ifdef PHASE_MASK
#define IN(k) (((PHASE_MASK >> (k)) & 1) && lo <= (k) && (k) < hi)
#else
#define IN(k) (lo <= (k) && (k) < hi)
#endif
#define BOTH(k) (IN(k) && IN((k) + 1))
#define MKFRAME Frame F; { const int t_ = fresh_tid(); F.tid = t_; F.lane = t_ & 63; F.wave = __builtin_amdgcn_readfirstlane(t_ >> 6); F.G = gridDim.x; const int bx = blockIdx.x; F.vcu = (F.G % 8 == 0) ? (bx % 8) * (F.G / 8) + bx / 8 : bx; }
#define PHASE_PTRS MKFRAME; KA A = fresh_args(); unsigned char* ws = A->ws; float* out = A->out; float* X = out + O_Y; float* ADA = (float*)(ws + WS_ADA); const float* ADA1 = ADA + (size_t)NADA * ADAW; \
    bf16* Hb = (bf16*)(ws + WS_H); bf16* Qb = (bf16*)(ws + WS_Q); bf16* Kb = (bf16*)(ws + WS_K); bf16* Vb = (bf16*)(ws + WS_V); bf16* Ob = (bf16*)(ws + WS_O); bf16* Ab = (bf16*)(ws + WS_A); \
    float* RSS = (float*)(ws + WS_CTL + CTL_RSS); bf16* SH = (bf16*)(ws + WS_SH); (void)RSS; (void)SH; (void)X; (void)ADA; (void)ADA1; (void)Hb; (void)Qb; (void)Kb; (void)Vb; (void)Ob; (void)Ab; (void)out

    if (IN(0)) { MKFRAME; p0_prologue(fresh_args(), F, ldsl); if (BOTH(0)) GRID_BAR(); }
    if (IN(1)) { PHASE_PTRS; norm_rows(A->in[0], A->in[1], A->in[11], ADA, 0, Hb, F); fill_shift_rows(ADA, SH, F); if (BOTH(1)) GRID_BAR(); }
    if (IN(2)) { PHASE_PTRS;
        { const int c = (int)blockIdx.x;
          if ((F.G % 8 == 0) && (F.G / 8 > NWORK) && (c >> 3) < NWORK) { const int wgw = ((c & 7) * NWORK + (c >> 3)) * NWAVES + F.wave;
              p0_copies(A, ldsl, F.wave, F.lane, wgw, I_FIN, NITEMS, wgw, 8 * NWORK * NWAVES, true); __syncthreads(); } }
        pg8::Gemm g{Hb, (const bf16*)(ws + WS_WFIN), MP, 3 * DM, DM};
        pg8::DynOrder S; S.init(MP, 3 * DM, (int)blockIdx.x, (unsigned*)(ws + WS_CTL) + CW_DYN, (int)(uintptr_t)(LAS char*)(MISC + 16));
        pg8::EpiFoxIn E{Qb, (size_t)(WS_K - WS_Q) / 2, out};
        pg8::gemm_phase<pg8::EpiFoxIn, pg8::DynOrder, true, true, true, false>(ldsl + RING_OFF, g, S, E);
        { const sk::SkFoxIn Es{Qb, Kb, Vb, (bf16*)(ws + WS_KC), (bf16*)(ws + WS_VC), out};
          sk::sk_gemm<2, true, false, sk::SkFoxIn>(Hb, MP, MS / 64, (const bf16*)(ws + WS_WFIN), 0, 3 * DM / 64, DM, (char*)lds + RING_OFF, Es, F.vcu, F.G);
          const sk::SkGates Eg{out, A->in[14], (float*)(ws + WS_LFH)};
          sk::sk_gemm<1, true, false, sk::SkGates>(Hb, 0, MT / 64, (const bf16*)(ws + WS_WFIN), 3 * DM, 1, DM, (char*)lds + RING_OFF, Eg, F.vcu, F.G, 248); }
        if (BOTH(2)) GRID_BAR();
    }
    if (IN(3)) { PHASE_PTRS; fox_norms(Qb, Kb, (float*)(ws + WS_QN), (float*)(ws + WS_KN), (float*)(ws + WS_SD), F); if (BOTH(3)) GRID_BAR(); }
    if (IN(4)) { MKFRAME; fox_scan(fresh_args(), F, ldsl); if (BOTH(4)) GRID_BAR(); }
    if (IN(5)) { PHASE_PTRS;
        const fox::Tensors T{Qb, Kb, Vb, Ob, (const bf16*)(ws + WS_KC), (const bf16*)(ws + WS_VC), (const bf16*)(ws + WS_CKP), (const bf16*)(ws + WS_CQP), (const bf16*)(ws + WS_CKS), (const bf16*)(ws + WS_CQS), (const int*)(ws + WS_JLO)};
        fox::fox_phase((char*)lds + RING_OFF, T, F.vcu, F.G);
        if (BOTH(5)) GRID_BAR();
    }
    if (IN(6)) { PHASE_PTRS;
        pg8::Gemm g{Ob, (const bf16*)(ws + WS_WFOUT), MP, DM, DM}; pg8::StaticOrder S; S.init(MP, DM, F.G, (int)blockIdx.x);
        pg8::EpiResid<true> E{A->in[0], X, ADA + 2 * DM, A->in[12], ADA + 4 * DM, Hb, RSS};
        pg8::gemm_phase<pg8::EpiResid<true>, pg8::StaticOrder, true, true>(ldsl + RING_OFF, g, S, E);
        { const sk::SkResid<true> Es{A->in[1], X + (size_t)MP * DM, ADA + 2 * DM, A->in[12], ADA + 4 * DM, Hb, RSS};
          sk::sk_gemm<2, false, false, sk::SkResid<true>>(Ob, MP, MS / 64, (const bf16*)(ws + WS_WFOUT), 0, DM / 64, DM, (char*)lds + RING_OFF, Es, F.vcu, F.G); }
        { const sk::SkSW E0{(float*)(ws + WS_SW0), DFF}, E1{(float*)(ws + WS_SW1), SWA_IN}, E2{(float*)(ws + WS_SW2), DFF};
          sk::sk_gemm<2, false, false, sk::SkSW>(SH, 0, 1, (const bf16*)(ws + WS_WUP), 0, DFF / 64, DM, (char*)lds + RING_OFF, E0, F.vcu, F.G, 128);
          sk::sk_gemm<2, false, false, sk::SkSW>(SH + 64 * DM, 0, 1, (const bf16*)(ws + WS_WSIN), 0, SWA_IN / 64, DM, (char*)lds + RING_OFF, E1, F.vcu, F.G, 128);
          sk::sk_gemm<2, false, false, sk::SkSW>(SH + 2 * 64 * DM, 0, 1, (const bf16*)(ws + WS_WUP) + (size_t)DM * DFF, 0, DFF / 64, DM, (char*)lds + RING_OFF, E2, F.vcu, F.G); }
        if (BOTH(6)) GRID_BAR();
    }
    if (IN(8)) { PHASE_PTRS;
        pg8::Gemm g{Hb, (const bf16*)(ws + WS_WUP), MP, DFF, DM}; pg8::StaticOrder S; S.init(MP, DFF, F.G, (int)blockIdx.x);
        pg8::EpiUp E{Ab, RSS, (const float*)(ws + WS_SW0)};
        pg8::gemm_phase<pg8::EpiUp, pg8::StaticOrder, true, true, true, false>(ldsl + RING_OFF, g, S, E);
        { const sk::SkUp Es{Ab, RSS, (const float*)(ws + WS_SW0)}; sk::sk_gemm<2, true, false, sk::SkUp>(Hb, MP, MS / 64, (const bf16*)(ws + WS_WUP), 0, DFF / 64, DM, (char*)lds + RING_OFF, Es, F.vcu, F.G); }
        if (BOTH(8)) GRID_BAR();
    }
    if (IN(9)) { PHASE_PTRS;
        pg8::Gemm g{Ab, (const bf16*)(ws + WS_WDN), MP, DM, DFF}; pg8::StaticOrder S; S.init(MP, DM, F.G, (int)blockIdx.x);
        pg8::EpiResid<true> E{X, X, ADA + 5 * DM, A->in[11] + DM, ADA1 + 1 * DM, Hb, RSS + MT};
        pg8::gemm_phase<pg8::EpiResid<true>, pg8::StaticOrder, true, true, true, false>(ldsl + RING_OFF, g, S, E);
        { const sk::SkResid<true> Es{X + (size_t)MP * DM, X + (size_t)MP * DM, ADA + 5 * DM, A->in[11] + DM, ADA1 + 1 * DM, Hb, RSS + MT};
          sk::sk_gemm<2, true, false, sk::SkResid<true>>(Ab, MP, MS / 64, (const bf16*)(ws + WS_WDN), 0, DM / 64, DFF, (char*)lds + RING_OFF, Es, F.vcu, F.G); }
        if (BOTH(9)) GRID_BAR();
    }
    if (IN(11)) { PHASE_PTRS;
        pg8::Gemm g{Hb, (const bf16*)(ws + WS_WSIN), MP, SWA_IN, DM}; pg8::StaticOrder S; S.init(MP, SWA_IN, F.G, (int)blockIdx.x);
        pg8::EpiSwaIn E{Qb, Kb, Vb, out, (const float*)(ws + WS_ROPE), RSS + MT, (const float*)(ws + WS_SW1)};
        pg8::gemm_phase<pg8::EpiSwaIn, pg8::StaticOrder, true, true, true, false>(ldsl + RING_OFF, g, S, E);
        { const sk::SkSwaIn Es{Qb, Kb, Vb, (bf16*)(ws + WS_KSC), (bf16*)(ws + WS_VSC), out, (const float*)(ws + WS_ROPE), RSS + MT, (const float*)(ws + WS_SW1)};
          sk::sk_gemm<2, true, false, sk::SkSwaIn>(Hb, MP, MS / 64, (const bf16*)(ws + WS_WSIN), 0, SWA_IN / 64, DM, (char*)lds + RING_OFF, Es, F.vcu, F.G); }
        if (BOTH(11)) GRID_BAR();
    }
    if (IN(12)) { PHASE_PTRS;
        const swa::Tensors T{Qb, Kb, Vb, Ob, (const bf16*)(ws + WS_KSC), (const bf16*)(ws + WS_VSC), A->in[17]};
        swa::swa_phase((char*)lds + RING_OFF, T, F.vcu, F.G);
        if (BOTH(12)) GRID_BAR();
    }
    if (IN(13)) { PHASE_PTRS;
        pg8::Gemm g{Ob, (const bf16*)(ws + WS_WSOUT), MP, DM, DM}; pg8::StaticOrder S; S.init(MP, DM, F.G, (int)blockIdx.x);
        pg8::EpiResid<true> E{X, X, ADA1 + 2 * DM, A->in[12] + DM, ADA1 + 4 * DM, Hb, RSS + 2 * MT};
        pg8::gemm_phase<pg8::EpiResid<true>, pg8::StaticOrder, true, true>(ldsl + RING_OFF, g, S, E);
        { const sk::SkResid<true> Es{X + (size_t)MP * DM, X + (size_t)MP * DM, ADA1 + 2 * DM, A->in[12] + DM, ADA1 + 4 * DM, Hb, RSS + 2 * MT};
          sk::sk_gemm<2, false, false, sk::SkResid<true>>(Ob, MP, MS / 64, (const bf16*)(ws + WS_WSOUT), 0, DM / 64, DM, (char*)lds + RING_OFF, Es, F.vcu, F.G); }
        if (BOTH(13)) GRID_BAR();
    }
    if (IN(15)) { PHASE_PTRS;
        pg8::Gemm g{Hb, (const bf16*)(ws + WS_WUP) + (size_t)DM * DFF, MP, DFF, DM}; pg8::StaticOrder S; S.init(MP, DFF, F.G, (int)blockIdx.x);
        pg8::EpiUp E{Ab, RSS + 2 * MT, (const float*)(ws + WS_SW2)};
        pg8::gemm_phase<pg8::EpiUp, pg8::StaticOrder, true, true, true, false>(ldsl + RING_OFF, g, S, E);
        { const sk::SkUp Es{Ab, RSS + 2 * MT, (const float*)(ws + WS_SW2)}; sk::sk_gemm<2, true, false, sk::SkUp>(Hb, MP, MS / 64, (const bf16*)(ws + WS_WUP) + (size_t)DM * DFF, 0, DFF / 64, DM, (char*)lds + RING_OFF, Es, F.vcu, F.G); }
        if (BOTH(15)) GRID_BAR();
    }
    if (IN(16)) { PHASE_PTRS;
        pg8::Gemm g{Ab, (const bf16*)(ws + WS_WDN) + (size_t)DM * DFF, MP, DM, DFF}; pg8::StaticOrder S; S.init(MP, DM, F.G, (int)blockIdx.x);
        pg8::EpiResid<false> E{X, X, ADA1 + 5 * DM, nullptr, nullptr, nullptr, nullptr};
        pg8::gemm_phase<pg8::EpiResid<false>, pg8::StaticOrder, true, true, true, false>(ldsl + RING_OFF, g, S, E);
        { const sk::SkResid<false> Es{X + (size_t)MP * DM, X + (size_t)MP * DM, ADA1 + 5 * DM, nullptr, nullptr, nullptr, nullptr};
          sk::sk_gemm<2, true, false, sk::SkResid<false>>(Ab, MP, MS / 64, (const bf16*)(ws + WS_WDN) + (size_t)DM * DFF, 0, DM / 64, DFF, (char*)lds + RING_OFF, Es, F.vcu, F.G); }
        if (BOTH(16)) GRID_BAR();
    }
    if (IN(17)) { PHASE_PTRS; final_norm(X, A->in[21], F); }
#undef PHASE_PTRS
#undef MKFRAME
#undef IN
#undef BOTH
#undef GRID_BAR
}

extern "C" void kernel_launch(void* const* d_in, const int* in_sizes, int n_in, void* d_out, int out_size, void* d_ws, size_t ws_size, hipStream_t stream) {
    static int grid = 0;
    if (grid == 0) {
        if (n_in != 22 || (size_t)out_size != O_END || ws_size < WS_END) { fprintf(stderr, "kernel_launch: shape mismatch n_in %d out %d (want %zu) ws %zu (want %zu)\n", n_in, out_size, (size_t)O_END, ws_size, (size_t)WS_END); grid = -1; return; }
        int dev = 0, cus = 0, per_cu = 0;
        if (hipGetDevice(&dev) != hipSuccess || hipDeviceGetAttribute(&cus, hipDeviceAttributeMultiprocessorCount, dev) != hipSuccess) { grid = -1; return; }
        if (hipFuncSetAttribute((const void*)mk_fwd, hipFuncAttributeMaxDynamicSharedMemorySize, LDS_BYTES) != hipSuccess) { fprintf(stderr, "kernel_launch: hipFuncSetAttribute failed\n"); grid = -1; return; }
        if (hipOccupancyMaxActiveBlocksPerMultiprocessor(&per_cu, (const void*)mk_fwd, NWAVES * 64, LDS_BYTES) != hipSuccess || per_cu < 1) { fprintf(stderr, "kernel_launch: occupancy query says %d\n", per_cu); }
        (void)hipGetLastError();
        grid = cus;
    }
    if (grid < 0) return;
    (void)hipMemsetAsync((char*)d_ws + WS_CTL, 0, CTL_ZERO_BYTES, stream);
    Args a{};
    for (int i = 0; i < 22; ++i) a.in[i] = (const float*)d_in[i];
    a.out = (float*)d_out; a.ws = (unsigned char*)d_ws;
    if (ONE_LAUNCH) { a.ph_lo = 0; a.ph_hi = N_PHASES; a.li = 0; hipLaunchKernelGGL(mk_fwd, dim3(grid), dim3(NWAVES * 64), LDS_BYTES, stream, a); }
    else { for (int p = 0; p < N_PHASES; ++p) { a.ph_lo = p; a.ph_hi = p + 1; a.li = p; hipLaunchKernelGGL(mk_fwd, dim3(grid), dim3(NWAVES * 64), LDS_BYTES, stream, a); } }
}
```

```cpp
#include <hip/hip_runtime.h>
#include <cstdio>
#include <cstdint>

constexpr int DM = 2048, NB = 2, SEQ = 16384, MP = NB * SEQ, DECB = 16, DECT = 32, MS = DECB * DECT, MT = MP + MS, PAST = 1024, DFF = 8192;
constexpr int FH = 16, FHD = 128, FOX_IN = 3 * DM + FH, FOX_IN_PAD = 6400;
constexpr int SWH = 32, SKV = 4, SHD = 64, SWA_IN = DM + 2 * SKV * SHD, WBUF = 128;
constexpr int NADA = 18, ADAW = 6 * DM;
constexpr float RMS_EPS = 1e-6f;
constexpr int KCROWS = 1088;
constexpr int SROWS = 160;

constexpr size_t O_Y = 0;
constexpr size_t O_FKP = (size_t)MT * DM;
constexpr size_t O_FVP = O_FKP + (size_t)MP * DM;
constexpr size_t O_FLP = O_FVP + (size_t)MP * DM;
constexpr size_t O_FKS = O_FLP + (size_t)MP * FH;
constexpr size_t O_FVS = O_FKS + (size_t)MS * DM;
constexpr size_t O_FLS = O_FVS + (size_t)MS * DM;
constexpr size_t O_SKP = O_FLS + (size_t)MS * FH;
constexpr size_t O_SVP = O_SKP + (size_t)NB * WBUF * 256;
constexpr size_t O_SKS = O_SVP + (size_t)NB * WBUF * 256;
constexpr size_t O_SVS = O_SKS + (size_t)DECB * WBUF * 256;
constexpr size_t O_END = O_SVS + (size_t)DECB * WBUF * 256;

constexpr size_t MiB = 1u << 20;
constexpr size_t WS_CTL = 0, CTL_ZERO_BYTES = 1 * MiB;
constexpr size_t WS_ADA = 1 * MiB;
constexpr size_t WS_ROPE = 3 * MiB;
constexpr size_t WS_SH = 4 * MiB;
constexpr size_t WS_SW0 = 5 * MiB;
constexpr size_t WS_SW1 = 6 * MiB;
constexpr size_t WS_SW2 = 7 * MiB;
constexpr size_t WS_KSC = 8 * MiB;
constexpr size_t WS_VSC = 10 * MiB;
constexpr size_t WS_WFIN = 12 * MiB;
constexpr size_t WS_WFOUT = 37 * MiB;
constexpr size_t WS_WSIN = 45 * MiB;
constexpr size_t WS_WSOUT = 55 * MiB;
constexpr size_t WS_WUP = 63 * MiB;
constexpr size_t WS_WDN = 127 * MiB;
constexpr size_t WS_H = 191 * MiB;
constexpr size_t WS_Q = 321 * MiB;
constexpr size_t WS_K = 451 * MiB;
constexpr size_t WS_V = 581 * MiB;
constexpr size_t WS_O = 711 * MiB;
constexpr size_t WS_A = WS_Q;
constexpr size_t WS_KC = 841 * MiB;
constexpr size_t WS_VC = 909 * MiB;
constexpr size_t WS_CKP = 977 * MiB;
constexpr size_t WS_CQP = 985 * MiB;
constexpr size_t WS_CKS = 993 * MiB;
constexpr size_t WS_CQS = 998 * MiB;
constexpr size_t WS_QN = 1003 * MiB;
constexpr size_t WS_KN = 1005 * MiB;
constexpr size_t WS_SD = 1007 * MiB;
constexpr size_t WS_JLO = 1009 * MiB;
constexpr size_t WS_LFH = 1010 * MiB;
constexpr size_t WS_END = 1012 * MiB;
static_assert((size_t)MT * DM * 2 == 130 * MiB && (size_t)MT * DFF * 2 == 520 * MiB && (size_t)DECB * KCROWS * DM * 2 == 68 * MiB, "map");

constexpr int CW_TMO = 0, CW_CODE = 1, CW_BAR = 4096, CW_DYN = 12288;
constexpr size_t CTL_RSS = 65536;
static_assert(CTL_RSS + 3 * (size_t)MT * 4 <= CTL_ZERO_BYTES, "rss inside the memset region");

#define GAS __attribute__((address_space(1)))
#define LAS __attribute__((address_space(3)))
typedef unsigned short bf16;
typedef unsigned v4u __attribute__((ext_vector_type(4)));
typedef unsigned v2u __attribute__((ext_vector_type(2)));
typedef float f32x4 __attribute__((ext_vector_type(4)));
typedef float f32x16 __attribute__((ext_vector_type(16)));
typedef short bf16x8 __attribute__((ext_vector_type(8)));
typedef short s16x4 __attribute__((ext_vector_type(4)));
typedef GAS unsigned gu32;
#define RLX_AGENT __ATOMIC_RELAXED, __HIP_MEMORY_SCOPE_AGENT
#define LDS_WAIT() asm volatile("s_waitcnt lgkmcnt(0)" ::: "memory")
#define VM_WAIT() asm volatile("s_waitcnt vmcnt(0)" ::: "memory")
__device__ __forceinline__ unsigned cvtpk(float lo, float hi) { unsigned r; asm volatile("v_cvt_pk_bf16_f32 %0, %1, %2" : "=v"(r) : "v"(lo), "v"(hi)); return r; }
__device__ __forceinline__ int arow_of(int row) { return row < MP ? (row >> 14) : 2 + ((row - MP) >> 5); }

__device__ __forceinline__ int fresh_tid() { int t = threadIdx.x; asm volatile("" : "+v"(t)); return t; }
__device__ __forceinline__ size_t tiled_off(int row, int k, int K) {
    const int r = row & 127, c = k & 63, st = (r >> 4) * 2 + (c >> 5), ob = (r & 15) * 64 + (c & 31) * 2;
    return ((size_t)(row >> 7) * (K >> 6) + (k >> 6)) * 16384 + st * 1024 + (ob ^ (((ob >> 9) & 1) << 5));
}
namespace pg8 {
#define PG8_LAS __attribute__((address_space(3)))
typedef unsigned short bf16_t;
typedef short bf16x8 __attribute__((ext_vector_type(8)));
typedef float f32x4 __attribute__((ext_vector_type(4)));
typedef unsigned u32x4 __attribute__((ext_vector_type(4)));
constexpr int BM = 256, BK = 64, HALF = 128, HTB = HALF * BK * 2  , STAGE_BYTES = 8 * HTB, NXCD = 8, WGM = 4;

__host__ __device__ __forceinline__ int lds_byte(int r, int c) { const int st = (r >> 4) * 2 + (c >> 5), rr = r & 15, cc = c & 31, ob = rr * 64 + cc * 2; return st * 1024 + (ob ^ (((ob >> 9) & 1) << 5)); }
__host__ __device__ __forceinline__ void stage_rc(int b, int& R, int& C) { const int st = b / 1024, sb = b % 1024, swz = sb ^ (((sb >> 9) & 1) << 5); R = (st >> 1) * 16 + swz / 64; C = (st & 1) * 32 + (swz % 64) / 2; }
__host__ __device__ __forceinline__ int perm32(int rho) { const int n = rho >> 4, i = rho & 15; return 8 * (i >> 2) + 4 * n + (i & 3); }

struct Unit { int pm, pn; };
struct Gemm { const bf16_t* A; const bf16_t* Bt; int M, N, K; };

struct StaticOrder {
    int nM, nN, nwg, G, c;
    __host__ __device__ void init(int M, int N, int G_, int c_) { nM = M / BM; nN = N / BM; nwg = nM * nN; G = G_; c = c_; }
    __host__ __device__ bool next(int i, Unit& u) const {
        const long L = (long)i * G + c; if (L >= nwg) return false;
        int wgid = (int)L; { const int q = nwg / NXCD, r = nwg % NXCD, xcd = wgid % NXCD, off = wgid / NXCD; wgid = (xcd < r ? xcd * (q + 1) : r * (q + 1) + (xcd - r) * q) + off; }
        const int nig = WGM * nN, gid = wgid / nig, fm = gid * WGM, gsz = (nM - fm) < WGM ? (nM - fm) : WGM;
        u.pm = fm + ((wgid % nig) % gsz); u.pn = (wgid % nig) / gsz; return true;
    }
    __device__ __forceinline__ void a_ready(const Unit&) const {}
    __device__ __forceinline__ int fetch(bool) const { return 0; }
    __device__ __forceinline__ void publish(int, bool, int) const {}
    __device__ __forceinline__ void done(const Unit&) const {}
};

struct DynOrder {
    int nM, nN, q, c, slot; unsigned* ctr;
    __device__ __forceinline__ int pack_tile(int wgid) const { const int nig = WGM * nN, gid = wgid / nig, fm = gid * WGM, gsz = (nM - fm) < WGM ? (nM - fm) : WGM;
        return ((fm + ((wgid % nig) % gsz)) << 8) | ((wgid % nig) / gsz); }
    __device__ __forceinline__ int draw() const { int got = -1;
        for (int k = 0; k < NXCD; ++k) { const int y = (c + k) & 7; const int n = (int)__hip_atomic_fetch_add(ctr + 64 * y, 1u, __ATOMIC_RELAXED, __HIP_MEMORY_SCOPE_AGENT); if (n < q) { got = pack_tile(y * q + n); break; } }
        return got; }
    __device__ __forceinline__ void init(int M, int N, int c_, unsigned* ctr_, int slot_) { nM = M / BM; nN = N / BM; q = nM * nN / NXCD; c = c_; ctr = ctr_; slot = slot_;
        if (threadIdx.x == 0) { const int u0 = draw(); const int u1 = u0 >= 0 ? draw() : -1; *(volatile PG8_LAS int*)(slot) = u0; *(volatile PG8_LAS int*)(slot + 4) = u1; }
        __syncthreads(); }
    __device__ __forceinline__ bool next(int i, Unit& u) const {
        const int v = __builtin_amdgcn_readfirstlane(*(volatile PG8_LAS int*)(slot + 4 * (i & 1))); if (v < 0) return false;
        u.pm = v >> 8; u.pn = v & 255; return true;
    }
    __device__ __forceinline__ void a_ready(const Unit&) const {}
    __device__ __forceinline__ int fetch(bool has_next) const { int got = -1; if (has_next && threadIdx.x == 0) got = draw(); return got; }
    __device__ __forceinline__ void publish(int i, bool has_next, int got) const { if (has_next && threadIdx.x == 0) *(volatile PG8_LAS int*)(slot + 4 * (i & 1)) = got; }
    __device__ __forceinline__ void done(const Unit&) const {}
};
__device__ __forceinline__ unsigned cvt_pk_bf16(float lo, float hi) { unsigned r; asm volatile("v_cvt_pk_bf16_f32 %0, %1, %2" : "=v"(r) : "v"(lo), "v"(hi)); return r; }

typedef unsigned u32x2 __attribute__((ext_vector_type(2)));
__device__ __forceinline__ u32x2 pack4(f32x4 v) { u32x2 w; w.x = cvt_pk_bf16(v[0], v[1]); w.y = cvt_pk_bf16(v[2], v[3]); return w; }

__device__ __forceinline__ u32x4 pack8(f32x4 a, f32x4 b) { u32x4 w; w.x = cvt_pk_bf16(a[0], a[1]); w.y = cvt_pk_bf16(a[2], a[3]); w.z = cvt_pk_bf16(b[0], b[1]); w.w = cvt_pk_bf16(b[2], b[3]); return w; }
struct EpiFoxIn {
    static constexpr bool PERM = true, AFTER_DRAIN = false;
    bf16_t* Q; size_t qkv_stride; float* out;
    __device__ __forceinline__ void operator()(const f32x4 (&acc)[2][2][4][2], const Unit& u, int wr, int wc, int fr, int fq) const {
        const int kind = u.pn >> 3, colt = (u.pn & 7) * 256;
        bf16_t* T = Q + (size_t)kind * qkv_stride; float* o = out + O_FKP + (size_t)(kind - 1) * ((size_t)MP * DM);
#pragma unroll
        for (int ai = 0; ai < 2; ++ai)
#pragma unroll
            for (int m = 0; m < 4; ++m) {
                const int row = u.pm * BM + ai * HALF + wr * 64 + m * 16 + fr;
#pragma unroll
                for (int bj = 0; bj < 2; ++bj) {
                    const int col = colt + bj * HALF + wc * 32 + fq * 8; const f32x4 v0 = acc[ai][bj][m][0], v1 = acc[ai][bj][m][1];
                    *(u32x4*)(T + (size_t)row * DM + col) = pack8(v0, v1);
                    if (kind != 0) { float* op = o + (size_t)row * DM + col; *(f32x4*)op = v0; *(f32x4*)(op + 4) = v1; }
                }
            }
    }
};
template <bool FUSE> struct EpiResid {
    static constexpr bool PERM = true, AFTER_DRAIN = false;
    const float* base; float* X; const float* gate;
    const float* ng; const float* nsc; bf16_t* H; float* rss;
    __device__ __forceinline__ void operator()(const f32x4 (&acc)[2][2][4][2], const Unit& u, int wr, int wc, int fr, int fq) const {
        const int b = u.pm >> 6; const float* gp = gate + (size_t)b * ADAW; const float* sp = nsc + (size_t)b * ADAW;
        f32x4 gv[2][2], cs[2][2];
#pragma unroll
        for (int bj = 0; bj < 2; ++bj)
#pragma unroll
            for (int n = 0; n < 2; ++n) { const int col = u.pn * BM + bj * HALF + wc * 32 + fq * 8 + n * 4; gv[bj][n] = *(const f32x4*)(gp + col);
                if (FUSE) cs[bj][n] = *(const f32x4*)(ng + col) * (*(const f32x4*)(sp + col) + 1.0f); }
#pragma unroll
        for (int ai = 0; ai < 2; ++ai)
#pragma unroll
            for (int m = 0; m < 4; ++m) {
                const int row = u.pm * BM + ai * HALF + wr * 64 + m * 16 + fr;
                const float* bp = base + (size_t)row * DM; float* xp = X + (size_t)row * DM; float ss = 0.f;
#pragma unroll
                for (int bj = 0; bj < 2; ++bj) {
                    const int col = u.pn * BM + bj * HALF + wc * 32 + fq * 8;
                    const f32x4 x0 = *(const f32x4*)(bp + col) + gv[bj][0] * acc[ai][bj][m][0], x1 = *(const f32x4*)(bp + col + 4) + gv[bj][1] * acc[ai][bj][m][1];
                    *(f32x4*)(xp + col) = x0; *(f32x4*)(xp + col + 4) = x1;
                    if (FUSE) { ss += ((x0[0] * x0[0] + x0[1] * x0[1]) + (x0[2] * x0[2] + x0[3] * x0[3])) + ((x1[0] * x1[0] + x1[1] * x1[1]) + (x1[2] * x1[2] + x1[3] * x1[3]));
                        *(u32x4*)(H + (size_t)row * DM + col) = pack8(x0 * cs[bj][0], x1 * cs[bj][1]); }
                }
                if (FUSE) { ss += __shfl_xor(ss, 16); ss += __shfl_xor(ss, 32);
                    if (fq == 0) (void)__hip_atomic_fetch_add(rss + row, ss, __ATOMIC_RELAXED, __HIP_MEMORY_SCOPE_AGENT); }
            }
    }
};
struct EpiUp {
    static constexpr bool PERM = true, AFTER_DRAIN = false;
    bf16_t* A; const float* rss; const float* sw;
    __device__ __forceinline__ void operator()(const f32x4 (&acc)[2][2][4][2], const Unit& u, int wr, int wc, int fr, int fq) const {
        const float* swp = sw + (size_t)(u.pm >> 6) * DFF; f32x4 sv[2][2];
#pragma unroll
        for (int bj = 0; bj < 2; ++bj)
#pragma unroll
            for (int n = 0; n < 2; ++n) sv[bj][n] = *(const f32x4*)(swp + u.pn * BM + bj * HALF + wc * 32 + fq * 8 + n * 4);
#pragma unroll
        for (int ai = 0; ai < 2; ++ai)
#pragma unroll
            for (int m = 0; m < 4; ++m) {
                const int row = u.pm * BM + ai * HALF + wr * 64 + m * 16 + fr; bf16_t* ap = A + (size_t)row * DFF;
                const float rstd = 1.0f / sqrtf(rss[row] * (1.0f / DM) + RMS_EPS);
#pragma unroll
                for (int bj = 0; bj < 2; ++bj) {
                    const int col = u.pn * BM + bj * HALF + wc * 32 + fq * 8; f32x4 v0 = acc[ai][bj][m][0] * rstd + sv[bj][0], v1 = acc[ai][bj][m][1] * rstd + sv[bj][1];
#pragma unroll
                    for (int e = 0; e < 4; ++e) { const float r0 = fmaxf(v0[e], 0.f), r1 = fmaxf(v1[e], 0.f); v0[e] = r0 * r0; v1[e] = r1 * r1; }
                    u32x4 w; w.x = cvt_pk_bf16(v0[0], v0[1]); w.y = cvt_pk_bf16(v0[2], v0[3]); w.z = cvt_pk_bf16(v1[0], v1[1]); w.w = cvt_pk_bf16(v1[2], v1[3]);
                    *(u32x4*)(ap + col) = w;
                }
            }
    }
};
struct EpiSwaIn {
    static constexpr bool PERM = true, AFTER_DRAIN = false;
    bf16_t *Q, *K, *V; float* out; const float* rope; const float* rss; const float* sw;
    __device__ __forceinline__ void operator()(const f32x4 (&acc)[2][2][4][2], const Unit& u, int wr, int wc, int fr, int fq) const {
        const int kind = u.pn < 8 ? 0 : (u.pn == 8 ? 1 : 2); const float* swp = sw + (size_t)(u.pm >> 6) * SWA_IN + u.pn * BM;
#pragma unroll
        for (int ai = 0; ai < 2; ++ai)
#pragma unroll
            for (int m = 0; m < 4; ++m) {
                const int row = u.pm * BM + ai * HALF + wr * 64 + m * 16 + fr, t = row & (SEQ - 1);
                const float rstd = 1.0f / sqrtf(rss[row] * (1.0f / DM) + RMS_EPS);
#pragma unroll
                for (int bj = 0; bj < 2; ++bj) {
                    const int c = bj * HALF + wc * 32 + fq * 8;
                    f32x4 v0 = acc[ai][bj][m][0] * rstd + *(const f32x4*)(swp + c), v1 = acc[ai][bj][m][1] * rstd + *(const f32x4*)(swp + c + 4);
                    if (kind != 2 && (wc & 1) == 0) {
                        f32x4 p0, p1;
#pragma unroll
                        for (int e = 0; e < 4; ++e) { p0[e] = __shfl_xor(v0[e], 16); p1[e] = __shfl_xor(v1[e], 16); }
                        const float* rp = rope + (size_t)t * 16;
                        const f32x4 c0 = *(const f32x4*)rp, c1 = *(const f32x4*)(rp + 4), s0 = *(const f32x4*)(rp + 8), s1 = *(const f32x4*)(rp + 12);
                        if (fq == 0) { v0 = v0 * c0 - p0 * s0; v1 = v1 * c1 - p1 * s1; } else if (fq == 1) { v0 = v0 * c0 + p0 * s0; v1 = v1 * c1 + p1 * s1; }
                    }
                    const u32x4 w = pack8(v0, v1);
                    if (kind == 0) { *(u32x4*)(Q + (size_t)row * DM + u.pn * BM + c) = w; }
                    else { bf16_t* T = kind == 1 ? K : V; *(u32x4*)(T + (size_t)row * 256 + c) = w;
                        if (t >= SEQ - WBUF) { float* op = out + (kind == 1 ? O_SKP : O_SVP) + ((size_t)(row >> 14) * WBUF + (t - (SEQ - WBUF))) * 256 + c; *(f32x4*)op = v0; *(f32x4*)(op + 4) = v1; } }
                }
            }
    }
};
template <class Epi, class Sched, bool ALIGN_EPI = false, bool SP2 = false, bool ATILED = false, bool BTILED = false>
__device__ __forceinline__ void gemm_phase(PG8_LAS unsigned char* lds, const Gemm g, const Sched& S, const Epi& E) {
    const int tid = fresh_tid(), wid = __builtin_amdgcn_readfirstlane(tid >> 6), lane = tid & 63, wr = wid >> 2, wc = wid & 3, fr = lane & 15, fq = lane >> 4;
    const int K = g.K, nt = K / BK;
    unsigned voffA[2], voffB[2];
#pragma unroll
    for (int i = 0; i < 2; ++i) { int R, C; stage_rc(tid * 16 + i * 8192, R, C); const int Rb = Epi::PERM ? ((R & ~31) + perm32(R & 31)) : R;
        voffA[i] = ATILED ? (unsigned)(tid * 16 + i * 8192) : (unsigned)(R * K + C) * 2u; voffB[i] = BTILED ? (unsigned)(tid * 16 + i * 8192) : (unsigned)(Rb * K + C) * 2u; }
    const size_t kstepA = ATILED ? (size_t)HTB : (size_t)(BK * 2), kstepB = BTILED ? (size_t)HTB : (size_t)(BK * 2);
    const size_t hstep = (size_t)HALF * K * 2;
    const size_t tstep = 2 * hstep;
    const unsigned ldsw = (unsigned)wid * 1024u;
    const int aoff = lds_byte(wr * 64 + fr, fq * 8), boff = lds_byte(wc * 32 + fr, fq * 8);
#define PG8_SA(b, h) (((b) * 2 + (h)) * HTB)
#define PG8_SB(b, h) ((4 + (b) * 2 + (h)) * HTB)
#define PG8_STAGE(bufoff, gbase, voff) do { _Pragma("unroll") for (int _i = 0; _i < 2; ++_i) \
        __builtin_amdgcn_global_load_lds((const unsigned*)((const char*)(gbase) + (voff)[_i]), (PG8_LAS unsigned*)(lds + (bufoff) + ldsw + _i * 8192), 16, 0, 0); } while (0)
#define PG8_LDA(dst, b, h) do { _Pragma("unroll") for (int m = 0; m < 4; ++m) _Pragma("unroll") for (int k = 0; k < 2; ++k) dst[m][k] = *(const PG8_LAS bf16x8*)(lds + PG8_SA(b, h) + aoff + m * 2048 + k * 1024); } while (0)
#define PG8_LDB(dst, b, h) do { _Pragma("unroll") for (int n = 0; n < 2; ++n) _Pragma("unroll") for (int k = 0; k < 2; ++k) dst[n][k] = *(const PG8_LAS bf16x8*)(lds + PG8_SB(b, h) + boff + n * 2048 + k * 1024); } while (0)
#define PG8_MMA(ai, bj, At, Bt) do { __builtin_amdgcn_s_setprio(1); _Pragma("unroll") for (int m = 0; m < 4; ++m) _Pragma("unroll") for (int n = 0; n < 2; ++n) _Pragma("unroll") for (int k = 0; k < 2; ++k) \
        acc[ai][bj][m][n] = __builtin_amdgcn_mfma_f32_16x16x32_bf16(Bt[n][k], At[m][k], acc[ai][bj][m][n], 0, 0, 0); __builtin_amdgcn_s_setprio(0); } while (0)
#define PG8_WAIT_V(n) asm volatile("s_waitcnt vmcnt(" #n ")" ::: "memory")
#define PG8_WAIT_L(n) asm volatile("s_waitcnt lgkmcnt(" #n ")" ::: "memory")
#define PG8_BAR __builtin_amdgcn_s_barrier()
#define PG8_SCHED __builtin_amdgcn_sched_barrier(0)
    Unit cur, nxt; int ui = 0;
    if (!S.next(0, cur)) return;
    f32x4 acc[2][2][4][2];
#pragma unroll
    for (int a = 0; a < 2; ++a)
#pragma unroll
        for (int b = 0; b < 2; ++b)
#pragma unroll
            for (int m = 0; m < 4; ++m)
#pragma unroll
                for (int n = 0; n < 2; ++n) acc[a][b][m][n] = (f32x4){0.f, 0.f, 0.f, 0.f};
    bf16x8 At[4][2], B0[2][2], B1[2][2];
    const char* cA = (const char*)g.A + (size_t)cur.pm * tstep; const char* cB = (const char*)g.Bt + (size_t)cur.pn * tstep;
    S.a_ready(cur);
    if constexpr (SP2) {
        PG8_STAGE(PG8_SB(0, 0), cB, voffB); PG8_STAGE(PG8_SB(0, 1), cB + hstep, voffB); PG8_STAGE(PG8_SA(0, 0), cA, voffA); PG8_STAGE(PG8_SA(0, 1), cA + hstep, voffA);
        if (wr == 1) PG8_BAR;
        PG8_WAIT_V(2); PG8_BAR;
        PG8_STAGE(PG8_SB(1, 0), cB + kstepB, voffB); PG8_STAGE(PG8_SA(1, 0), cA + kstepA, voffA); PG8_STAGE(PG8_SB(1, 1), cB + hstep + kstepB, voffB);
        PG8_WAIT_V(6); PG8_BAR;
    } else {
        PG8_STAGE(PG8_SB(0, 0), cB, voffB); PG8_STAGE(PG8_SA(0, 0), cA, voffA); PG8_STAGE(PG8_SB(0, 1), cB + hstep, voffB); PG8_STAGE(PG8_SA(0, 1), cA + hstep, voffA);
        if (wr == 1) PG8_BAR;
        PG8_WAIT_V(4); PG8_BAR;
        PG8_STAGE(PG8_SB(1, 0), cB + kstepB, voffB); PG8_STAGE(PG8_SA(1, 0), cA + kstepA, voffA); PG8_STAGE(PG8_SB(1, 1), cB + hstep + kstepB, voffB);
        PG8_WAIT_V(6); PG8_BAR;
    }
    for (;;) {
        bool has_next = false; int fetched = -1;
        const char* nA = cA; const char* nB = cB;
        for (int t = 0; t < nt; t += 2) {
            const bool last = (t == nt - 2);
            if (last) { has_next = S.next(ui + 1, nxt); if (has_next) { nA = (const char*)g.A + (size_t)nxt.pm * tstep; nB = (const char*)g.Bt + (size_t)nxt.pn * tstep; } }
            const char* a1 = cA + (size_t)(t + 1) * kstepA;
            const char* a2 = last ? nA : cA + (size_t)(t + 2) * kstepA; const char* b2 = last ? nB : cB + (size_t)(t + 2) * kstepB;
            const char* a3 = a2 + kstepA; const char* b3 = b2 + kstepB;
            if (last && has_next) S.a_ready(nxt);
            if constexpr (SP2) {
            PG8_LDB(B0, 0, 0); PG8_LDB(B1, 0, 1); PG8_SCHED; PG8_LDA(At, 0, 0); PG8_STAGE(PG8_SA(1, 1), a1 + hstep, voffA);
            PG8_WAIT_V(8); PG8_WAIT_L(0); PG8_BAR; PG8_MMA(0, 0, At, B0); PG8_MMA(0, 1, At, B1); PG8_BAR; PG8_SCHED;
            PG8_LDA(At, 0, 1); PG8_STAGE(PG8_SB(0, 0), b2, voffB); PG8_STAGE(PG8_SB(0, 1), b2 + hstep, voffB); PG8_STAGE(PG8_SA(0, 0), a2, voffA);
            PG8_WAIT_V(8); PG8_WAIT_L(0); PG8_BAR; PG8_MMA(1, 0, At, B0); PG8_MMA(1, 1, At, B1); PG8_BAR; PG8_SCHED;
            PG8_LDB(B0, 1, 0); PG8_LDB(B1, 1, 1); PG8_SCHED; PG8_LDA(At, 1, 0); PG8_STAGE(PG8_SA(0, 1), a2 + hstep, voffA);
            PG8_WAIT_V(8); PG8_WAIT_L(0); PG8_BAR; PG8_MMA(0, 0, At, B0); PG8_MMA(0, 1, At, B1); PG8_BAR; PG8_SCHED;
            PG8_LDA(At, 1, 1); PG8_STAGE(PG8_SB(1, 0), b3, voffB); PG8_STAGE(PG8_SB(1, 1), b3 + hstep, voffB); PG8_STAGE(PG8_SA(1, 0), a3, voffA);
            PG8_WAIT_V(8); PG8_WAIT_L(0); PG8_BAR; PG8_MMA(1, 0, At, B0); PG8_MMA(1, 1, At, B1); PG8_BAR; PG8_SCHED;
            } else {
            PG8_LDB(B0, 0, 0); PG8_SCHED; PG8_LDA(At, 0, 0); PG8_STAGE(PG8_SA(1, 1), a1 + hstep, voffA);
            PG8_WAIT_L(8); PG8_BAR; PG8_WAIT_L(0); PG8_MMA(0, 0, At, B0); PG8_BAR; PG8_SCHED;
            PG8_LDB(B1, 0, 1); PG8_STAGE(PG8_SB(0, 0), b2, voffB);
            PG8_BAR; PG8_WAIT_L(0); PG8_MMA(0, 1, At, B1); PG8_BAR;
            PG8_LDA(At, 0, 1); PG8_STAGE(PG8_SA(0, 0), a2, voffA);
            PG8_BAR; PG8_WAIT_L(0); PG8_MMA(1, 0, At, B0); PG8_BAR; PG8_SCHED;
            PG8_STAGE(PG8_SB(0, 1), b2 + hstep, voffB);
            PG8_WAIT_V(6); PG8_BAR; PG8_MMA(1, 1, At, B1); PG8_BAR;
            PG8_LDB(B0, 1, 0); PG8_SCHED; PG8_LDA(At, 1, 0); PG8_STAGE(PG8_SA(0, 1), a2 + hstep, voffA);
            PG8_WAIT_L(8); PG8_BAR; PG8_WAIT_L(0); PG8_MMA(0, 0, At, B0); PG8_BAR; PG8_SCHED;
            PG8_LDB(B1, 1, 1); PG8_STAGE(PG8_SB(1, 0), b3, voffB);
            PG8_BAR; PG8_WAIT_L(0); PG8_MMA(0, 1, At, B1); PG8_BAR;
            PG8_LDA(At, 1, 1); PG8_STAGE(PG8_SA(1, 0), a3, voffA);
            PG8_BAR; PG8_WAIT_L(0); PG8_MMA(1, 0, At, B0); PG8_BAR; PG8_SCHED;
            PG8_STAGE(PG8_SB(1, 1), b3 + hstep, voffB);
            PG8_WAIT_V(6); PG8_BAR; PG8_MMA(1, 1, At, B1); PG8_BAR;
            }
        }
        if constexpr (ALIGN_EPI) { if (wr == 0) PG8_BAR; }
        if constexpr (!Epi::AFTER_DRAIN) { fetched = S.fetch(has_next); E(acc, cur, wr, wc, fr, fq); S.publish(ui, has_next, fetched); S.done(cur); }
        if (!has_next) break;
#pragma unroll
        for (int a = 0; a < 2; ++a)
#pragma unroll
            for (int b = 0; b < 2; ++b)
#pragma unroll
                for (int m = 0; m < 4; ++m)
#pragma unroll
                    for (int n = 0; n < 2; ++n) acc[a][b][m][n] = (f32x4){0.f, 0.f, 0.f, 0.f};
        cur = nxt; cA = nA; cB = nB; ++ui;
        if constexpr (ALIGN_EPI) { if (wr == 1) PG8_BAR; }
    }
    PG8_WAIT_V(0);
    if constexpr (!ALIGN_EPI) { if (wr == 0) PG8_BAR; }
    PG8_BAR;
    if constexpr (Epi::AFTER_DRAIN) { E.fused(acc, cur, wr, wc, fr, fq, lds, wid, lane); S.done(cur); }
#undef PG8_SA
#undef PG8_SB
#undef PG8_STAGE
#undef PG8_LDA
#undef PG8_LDB
#undef PG8_MMA
#undef PG8_WAIT_V
#undef PG8_WAIT_L
#undef PG8_BAR
#undef PG8_SCHED
}
}

namespace fox {
constexpr int D = 128, PITCH = 2048;
constexpr float SCALE = 0.08838834764831845f;
constexpr float THR = 8.f;
constexpr int NW = 8, QBLK = 32, KVBLK = 64, QB = NW * QBLK;
constexpr int SHM_V = KVBLK * D * 2, SHM_K = KVBLK * D * 2;
constexpr int OFF_WS = 2 * SHM_V + 2 * SHM_K, OFF_C = OFF_WS + NW * 64 * 4, LDS_BYTES = OFF_C + 3104;
#define KSWZ(row, colB) ((row) * 256 + ((colB) ^ (((row) & 7) << 4)))
#define SBAR() __builtin_amdgcn_sched_barrier(0)
__device__ __forceinline__ int v_st(int k, int c) { const int kk = (k & ~0xC) | ((k & 4) << 1) | ((k & 8) >> 1); return ((kk >> 3) * 4 + (c >> 5)) * 512 + ((kk & 7) * 32 + (c & 31)) * 2; }
__device__ __forceinline__ int v_rd_base(int lane) { return ((lane & 3) << 3) | (((lane >> 2) & 3) << 6) | (((lane >> 4) & 1) << 5) | (((lane >> 5) & 1) << 8); }
constexpr int v_rd_off(int d0, int ks, int half) { return d0 * 512 + ks * 4096 + half * 2048; }
__device__ __forceinline__ int crow(int r, int hi) { return (r & 3) + 8 * (r >> 2) + 4 * hi; }
__device__ __forceinline__ bf16x8 load8(const bf16* p) { return *reinterpret_cast<const bf16x8*>(p); }
__device__ __forceinline__ void mask_tile(f32x16& p0, f32x16& p1, int dq) {
    const float NEG = -__builtin_inff();
#pragma unroll
    for (int r = 0; r < 16; ++r) {
        const int c = (r & 3) + 8 * (r >> 2);
        if (dq - c < 0) p0[r] = NEG;
        if (dq - c - 32 < 0) p1[r] = NEG;
    }
}
__device__ __forceinline__ void partialSM(f32x16& p0, f32x16& p1, float& m_reg, float& mn, float& alpha) {
    float pmax = p0[0]; for (int r = 1; r < 16; ++r) pmax = fmaxf(pmax, p0[r]); for (int r = 0; r < 16; ++r) pmax = fmaxf(pmax, p1[r]);
    { auto rr = __builtin_amdgcn_permlane32_swap(__float_as_uint(pmax), __float_as_uint(pmax), false, false);
      pmax = fmaxf(__uint_as_float(rr[0]), __uint_as_float(rr[1])); }
    constexpr float C2 = 1.4426950408889634f * SCALE;
    if (__builtin_expect(__all((pmax - m_reg) * SCALE <= THR), 1)) { mn = m_reg; alpha = 1.f; }
    else { mn = fmaxf(m_reg, pmax); alpha = __builtin_amdgcn_exp2f((m_reg - mn) * C2); m_reg = mn; }
    const float mnL = -mn * C2;
    for (int r = 0; r < 16; ++r) p0[r] = fmaf(p0[r], C2, mnL); for (int r = 0; r < 16; ++r) p1[r] = fmaf(p1[r], C2, mnL);
    for (int r = 0; r < 16; ++r) p0[r] = __builtin_amdgcn_exp2f(p0[r]);
}
__device__ __forceinline__ void finishSM(f32x16& p0, f32x16& p1, float alpha, float& l_reg, bf16x8& pa0, bf16x8& pa1, bf16x8& pa2, bf16x8& pa3) {
    for (int r = 0; r < 16; ++r) p1[r] = __builtin_amdgcn_exp2f(p1[r]);
    float ps = 0; for (int r = 0; r < 16; ++r) ps += p0[r]; for (int r = 0; r < 16; ++r) ps += p1[r];
    { auto rr = __builtin_amdgcn_permlane32_swap(__float_as_uint(ps), __float_as_uint(ps), false, false);
      ps = __uint_as_float(rr[0]) + __uint_as_float(rr[1]); }
    l_reg = l_reg * alpha + ps;
#define PK4(P, B_, OUT) do { unsigned a0 = cvtpk(P[B_+0], P[B_+1]), a1 = cvtpk(P[B_+2], P[B_+3]);                          \
        unsigned b0 = cvtpk(P[B_+4], P[B_+5]), b1 = cvtpk(P[B_+6], P[B_+7]);                                             \
        auto r0 = __builtin_amdgcn_permlane32_swap(a0, b0, false, false); auto r1 = __builtin_amdgcn_permlane32_swap(a1, b1, false, false); \
        v4u w = {r0[0], r1[0], r0[1], r1[1]}; OUT = *reinterpret_cast<bf16x8*>(&w); } while (0)
    PK4(p0, 0, pa0); PK4(p0, 8, pa1); PK4(p1, 0, pa2); PK4(p1, 8, pa3);
}
template <int KB>
__device__ __forceinline__ void qkt(f32x16& p0, f32x16& p1, const char* K_lds, const char* C_lds, int r32, int hi, const bf16x8* qr, bf16x8 cqf, int caddr) {
    const bf16x8 ca = *reinterpret_cast<const bf16x8*>(C_lds + KB * 1024 + caddr);
    const bf16x8 cb = *reinterpret_cast<const bf16x8*>(C_lds + KB * 1024 + caddr + (hi ? 0 : 512));
    p0 = __builtin_amdgcn_mfma_f32_32x32x16_bf16(ca, cqf, f32x16{}, 0, 0, 0);
    p1 = __builtin_amdgcn_mfma_f32_32x32x16_bf16(cb, cqf, f32x16{}, 0, 0, 0);
    const char* kb[4];
#pragma unroll
    for (int dd = 0; dd < 4; ++dd) kb[dd] = K_lds + KB * SHM_K + KSWZ(r32, (dd * 16 + hi * 8) * 2);
#pragma unroll
    for (int d0 = 0; d0 < 8; ++d0) { const char* a = kb[d0 & 3] + (d0 >> 2) * 128;
        bf16x8 b0 = *reinterpret_cast<const bf16x8*>(a);
        bf16x8 b1 = *reinterpret_cast<const bf16x8*>(a + 32 * 256);
        p0 = __builtin_amdgcn_mfma_f32_32x32x16_bf16(b0, qr[d0], p0, 0, 0, 0);
        p1 = __builtin_amdgcn_mfma_f32_32x32x16_bf16(b1, qr[d0], p1, 0, 0, 0); }
}
template <int VB>
__device__ __forceinline__ void pv_tile(f32x16* o, int vb0, bf16x8 pa0, bf16x8 pa1, bf16x8 pa2, bf16x8 pa3) {
#define TRRD(dst, off) asm volatile("ds_read_b64_tr_b16 %0, %1 offset:%2" : "=&v"(dst) : "v"(vb0), "i"(off) : "memory")
#define PV_D0(d0) do { s16x4 l0, l1, l2, l3, h0, h1, h2, h3; constexpr int b_ = VB * SHM_V + v_rd_off(d0, 0, 0); \
        TRRD(l0, b_); TRRD(h0, b_ + 2048); TRRD(l1, b_ + 4096); TRRD(h1, b_ + 6144); TRRD(l2, b_ + 8192); TRRD(h2, b_ + 10240); TRRD(l3, b_ + 12288); TRRD(h3, b_ + 14336); \
        asm volatile("s_waitcnt lgkmcnt(0)" ::: "memory"); SBAR();   \
        o[d0] = __builtin_amdgcn_mfma_f32_32x32x16_bf16(pa0, (bf16x8){l0[0], l0[1], l0[2], l0[3], h0[0], h0[1], h0[2], h0[3]}, o[d0], 0, 0, 0);   \
        o[d0] = __builtin_amdgcn_mfma_f32_32x32x16_bf16(pa1, (bf16x8){l1[0], l1[1], l1[2], l1[3], h1[0], h1[1], h1[2], h1[3]}, o[d0], 0, 0, 0);   \
        o[d0] = __builtin_amdgcn_mfma_f32_32x32x16_bf16(pa2, (bf16x8){l2[0], l2[1], l2[2], l2[3], h2[0], h2[1], h2[2], h2[3]}, o[d0], 0, 0, 0);   \
        o[d0] = __builtin_amdgcn_mfma_f32_32x32x16_bf16(pa3, (bf16x8){l3[0], l3[1], l3[2], l3[3], h3[0], h3[1], h3[2], h3[3]}, o[d0], 0, 0, 0); } while (0)
    PV_D0(0); PV_D0(1); PV_D0(2); PV_D0(3);
#undef PV_D0
#undef TRRD
}
struct BlockRef { unsigned q0, k0, c0; int P0, wstride, jlo, jhi, samp; };
struct Tensors { const bf16* Q; const bf16* K; const bf16* V; bf16* O; const bf16* KC; const bf16* VC; const bf16* CKP; const bf16* CQP; const bf16* CKS; const bf16* CQS; const int* JLO; };
#define BR_Q(r) (T.Q + (r).q0)
#define BR_O(r) (T.O + (r).q0)
#define BR_K(r) (((r).samp ? T.KC : T.K) + (r).k0)
#define BR_V(r) (((r).samp ? T.VC : T.V) + (r).k0)
#define BR_CK(r) (((r).samp ? T.CKS : T.CKP) + (r).c0)
#define BR_CQ(r) (((r).samp ? T.CQS : T.CQP) + (r).c0)
struct Seam { bf16x8 qr[8]; bf16x8 st_v0, st_v1, st_k0, st_k1; bf16x8 cqf; };
#define VMW() asm volatile("s_waitcnt vmcnt(0)" ::: "memory")
#define VMWN(n) asm volatile("s_waitcnt vmcnt(%0)" :: "i"(n) : "memory")
#define SLOAD_H(Kp, Vp, Cp, k0) do { const bf16* vb_ = (Vp) + (size_t)(k0) * PITCH; const bf16* kb_ = (Kp) + (size_t)(k0) * PITCH;              \
                         S.st_v0 = load8(vb_ + loff); S.st_v1 = load8(vb_ + 32 * PITCH + loff);              \
                         S.st_k0 = load8(kb_ + loff); S.st_k1 = load8(kb_ + 32 * PITCH + loff); } while (0)
#define SWRITE_HK(bf) do { *(bf16x8*)(K_lds + (bf) * SHM_K + kws) = S.st_k0; *(bf16x8*)(K_lds + (bf) * SHM_K + kws + 32 * 256) = S.st_k1; } while (0)
#define CDMA(Cp, k0, bf) do { if (wid == 0) __builtin_amdgcn_global_load_lds((const unsigned*)((const char*)((Cp) + (size_t)(k0) * 8) + coff), (LAS unsigned*)(C_lds + (bf) * 1024), 16, 0, 0); } while (0)
#define SWRITE_HV(bf) do { *(bf16x8*)(V_lds + (bf) * SHM_V + vst0) = S.st_v0; *(bf16x8*)(V_lds + (bf) * SHM_V + vst1) = S.st_v1; } while (0)
#define SWRITE_H(bf) do { SWRITE_HV(bf); SWRITE_HK(bf); } while (0)
__device__ __forceinline__ void fox_prime(const BlockRef& cur, const Tensors& T, char* lds, Seam& S) {
    const int tid = fresh_tid(), wid = __builtin_amdgcn_readfirstlane(tid >> 6), lane = tid & 63, r32 = lane & 31, hi = lane >> 5;
    const int sr = tid >> 4, sc = (tid & 15) * 8, kws = KSWZ(sr, sc * 2); char* K_lds = lds + 2 * SHM_V; char* C_lds = lds + OFF_C;
    const unsigned loff = (unsigned)(sr * PITCH + sc), qoff = (unsigned)(r32 * PITCH + hi * 8), coff = (unsigned)lane * 16u;
    if (tid < 8) { *(unsigned*)(C_lds + 2048 + (tid & 3) * 4 + (tid >> 2) * 1024) = 0u; }
    { const bf16* qb_ = BR_Q(cur) + (size_t)(wid * cur.wstride) * PITCH;
      for (int d0 = 0; d0 < 8; ++d0) S.qr[d0] = load8(qb_ + qoff + d0 * 16); }
    S.cqf = (bf16x8){0, 0, 0, 0, 0, 0, 0, 0};
    if (hi == 0) S.cqf = load8(BR_CQ(cur) + (size_t)(cur.P0 + wid * cur.wstride) * 8 + (unsigned)(r32 * 8));
    CDMA(BR_CK(cur), cur.jlo * KVBLK, 0);
    SLOAD_H(BR_K(cur), BR_V(cur), 0, cur.jlo * KVBLK); VMW(); SWRITE_HK(0);
    __syncthreads();
}
template <bool SAMP>
__device__ __forceinline__ void fox_block(const BlockRef& cur, const BlockRef& nxt, const Tensors& T, char* lds, Seam& S) {
    const int tid = fresh_tid(), wid = __builtin_amdgcn_readfirstlane(tid >> 6), lane = tid & 63, r32 = lane & 31, hi = lane >> 5;
    const int NT = cur.jhi - cur.jlo, j_lo = cur.jlo;
    const bool act = !SAMP || wid == 0;
#define ACTV(x) do { if (act) { x; } } while (0)
    const int qlo = cur.P0 + wid * cur.wstride, qm = qlo + r32 - 4 * hi;
    char* V_lds = lds; char* K_lds = lds + 2 * SHM_V; char* C_lds = lds + OFF_C;
    float* ws = (float*)(lds + OFF_WS) + wid * 64; float* li_l = ws, * al_l = ws + 32;
    float m_reg = -1e30f, l_reg = 0; f32x16 o[4] = {};
    const int sr = tid >> 4, sc = (tid & 15) * 8, vst0 = v_st(sr, sc), vst1 = v_st(32 + sr, sc), kws = KSWZ(sr, sc * 2);
    const int vb0 = (int)(uintptr_t)V_lds + v_rd_base(lane);
    const int caddr = hi ? 2048 : r32 * 16;
    const unsigned loff = (unsigned)(sr * PITCH + sc), qoff = (unsigned)(r32 * PITCH + hi * 8), coff = (unsigned)lane * 16u;
    const bf16* Kh = BR_K(cur); const bf16* Vh = BR_V(cur); const bf16* Ch = BR_CK(cur); const bf16x8 cqf = S.cqf;
#define RESC(a) do { if (__any((a) < 1.f)) { if (hi == 0) al_l[r32] = (a); asm volatile("s_waitcnt lgkmcnt(0)" ::: "memory");              \
                     for (int d_ = 0; d_ < 4; ++d_) for (int r = 0; r < 16; ++r) o[d_][r] *= al_l[crow(r, hi)]; } } while (0)
#define KBASE(t) ((j_lo + (t)) * KVBLK)
#define MASKT(P0_, P1_, t) do { const int kb_ = KBASE(t); if (kb_ + KVBLK - 1 > qlo) mask_tile(P0_, P1_, qm - kb_); } while (0)
    constexpr int NQL = 9;
#define SEAM_K0() do { VMWN(NQL); SWRITE_HK(0); SBAR(); } while (0)
    f32x16 pA0, pA1, pB0, pB1; float mnA, mnB, alA, alB; bf16x8 pa0, pa1, pa2, pa3;
    SWRITE_HV(0); SBAR();
    if (NT > 1) { CDMA(Ch, KBASE(1), 1); SLOAD_H(Kh, Vh, Ch, KBASE(1)); }
    SBAR(); ACTV(qkt<0>(pA0, pA1, K_lds, C_lds, r32, hi, S.qr, cqf, caddr);
    MASKT(pA0, pA1, 0); partialSM(pA0, pA1, m_reg, mnA, alA));
    if (NT > 1) { VMW(); SWRITE_H(1); }
    __syncthreads();
#define HALF_STEP(PX0, PX1, mnX, alX, PY0, PY1, alY, t, KB, VB, SB) do {                                                      \
        SBAR(); ACTV(qkt<KB>(PX0, PX1, K_lds, C_lds, r32, hi, S.qr, cqf, caddr);                                             \
        finishSM(PY0, PY1, alY, l_reg, pa0, pa1, pa2, pa3)); SBAR();                                                           \
        if ((t) + 1 < NT) { CDMA(Ch, KBASE((t) + 1), SB); SLOAD_H(Kh, Vh, Ch, KBASE((t) + 1)); SBAR(); }                                               \
        ACTV(pv_tile<VB>(o, vb0, pa0, pa1, pa2, pa3); MASKT(PX0, PX1, (t)); partialSM(PX0, PX1, m_reg, mnX, alX));                                        \
        __syncthreads();                                                                                                      \
        if ((t) + 1 < NT) { VMW(); SWRITE_H(SB); }                                                                          \
        ACTV(RESC(alX)); __syncthreads(); } while (0)
    for (int t = 1; t + 1 < NT; t += 2) {
        HALF_STEP(pB0, pB1, mnB, alB, pA0, pA1, alA, t, 1, 0, 0);
        HALF_STEP(pA0, pA1, mnA, alA, pB0, pB1, alB, t + 1, 0, 1, 1);
    }
    const bool even = (NT & 1) == 0;
    if (even) { SBAR(); ACTV(qkt<1>(pB0, pB1, K_lds, C_lds, r32, hi, S.qr, cqf, caddr)); SBAR(); }
    CDMA(BR_CK(nxt), nxt.jlo * KVBLK, 0); SLOAD_H(BR_K(nxt), BR_V(nxt), 0, nxt.jlo * KVBLK); SBAR();
    { const bf16* qb_ = BR_Q(nxt) + (size_t)(wid * nxt.wstride) * PITCH;
#pragma unroll
      for (int d0 = 0; d0 < 8; ++d0) S.qr[d0] = load8(qb_ + qoff + d0 * 16); }
    S.cqf = (bf16x8){0, 0, 0, 0, 0, 0, 0, 0};
    if (hi == 0) S.cqf = load8(BR_CQ(nxt) + (size_t)(nxt.P0 + wid * nxt.wstride) * 8 + (unsigned)(r32 * 8));
    SBAR();
    ACTV(finishSM(pA0, pA1, alA, l_reg, pa0, pa1, pa2, pa3)); SBAR();
    ACTV(pv_tile<0>(o, vb0, pa0, pa1, pa2, pa3));
    if (even) { ACTV(MASKT(pB0, pB1, NT - 1); partialSM(pB0, pB1, m_reg, mnB, alB)); __syncthreads(); ACTV(RESC(alB);
        finishSM(pB0, pB1, alB, l_reg, pa0, pa1, pa2, pa3)); SBAR(); ACTV(pv_tile<1>(o, vb0, pa0, pa1, pa2, pa3)); }
    SBAR(); SEAM_K0();
    if (hi == 0) li_l[r32] = l_reg; asm volatile("s_waitcnt lgkmcnt(0)" ::: "memory");
    float rli[16];
#pragma unroll
    for (int r = 0; r < 16; ++r) rli[r] = __builtin_amdgcn_rcpf(li_l[crow(r, hi)]);
    __syncthreads();
    if (cur.wstride != 0 || wid == 0) {
        bf16* Ow = BR_O(cur) + (size_t)(wid * cur.wstride) * PITCH; char* stg = V_lds + wid * 4096;
        const unsigned srow = (unsigned)(lane >> 3), sch = (unsigned)(lane & 7);
#pragma unroll
        for (int h2 = 0; h2 < 2; ++h2) {
#pragma unroll
            for (int r = 0; r < 16; ++r) { const int orow = crow(r, hi);
#pragma unroll
                for (int d0 = 0; d0 < 2; ++d0) *(bf16*)(stg + orow * 128 + (d0 * 32 + r32) * 2) = (bf16)(cvtpk(o[2 * h2 + d0][r] * rli[r], 0.f) & 0xffffu); }
            asm volatile("s_waitcnt lgkmcnt(0)" ::: "memory");
#pragma unroll
            for (int i = 0; i < 4; ++i) { const unsigned row = i * 8 + srow; const v4u v = *(const v4u*)(stg + row * 128 + sch * 16);
                *(v4u*)(Ow + (size_t)row * PITCH + h2 * 64 + sch * 8) = v; }
            asm volatile("s_waitcnt lgkmcnt(0)" ::: "memory");
        }
    }
    __syncthreads();
#undef ACTV
#undef RESC
#undef KBASE
#undef MASKT
#undef SEAM_K0
#undef HALF_STEP
}
#undef VMW
#undef VMWN
#undef SLOAD_H
#undef SWRITE_HK
#undef SWRITE_HV
#undef SWRITE_H
#undef CDMA
#undef PK4
#undef KSWZ
__device__ __forceinline__ BlockRef fox_ref(int L, int pass, const int* JLO) {
    BlockRef r;
    if (L < 1024) { const int i = L >> 8, v = L & 255, bh = (v >> 5) + 8 * i, j = v & 31, qb = pass == 0 ? 63 - j : j, b = bh >> 4, h = bh & 15;
        r.q0 = (unsigned)((b * SEQ + qb * QB) * PITCH + h * D); r.k0 = (unsigned)(b * SEQ * PITCH + h * D); r.c0 = (unsigned)(bh * SEQ * 8); r.P0 = qb * QB; r.wstride = QBLK; r.jhi = 4 * (qb + 1); r.samp = 0; r.jlo = JLO[bh * (SEQ / QB) + qb]; }
    else { const int s = L - 1024, b = s >> 4, h = s & 15;
        r.q0 = (unsigned)((MP + b * DECT) * PITCH + h * D); r.k0 = (unsigned)(b * KCROWS * PITCH + h * D); r.c0 = (unsigned)(s * KCROWS * 8); r.P0 = PAST; r.wstride = 0; r.jhi = (PAST + DECT + KVBLK - 1) / KVBLK; r.samp = 1; r.jlo = 0; }
    return r;
}
__device__ __forceinline__ void fox_phase(char* lds, const Tensors& T, int vcu, int G) {
    constexpr int TOTAL = 1024 + DECB * FH;
    int L = vcu; if (L >= TOTAL) return;
    int pass = 0;
    BlockRef cur = fox_ref(L, 0, T.JLO);
    Seam S;
    fox_prime(cur, T, lds, S);
    bool done = false;
    while (!cur.samp) {
        const bool more_pass = pass == 0, more_item = L + G < TOTAL, last = !more_pass && !more_item;
        int passn = pass + 1, Ln = L;
        if (!more_pass) { passn = 0; Ln = more_item ? L + G : L; }
        const BlockRef nxt = last ? cur : fox_ref(Ln, passn, T.JLO);
        fox_block<false>(cur, nxt, T, lds, S);
        if (last) { done = true; break; }
        cur = nxt; pass = passn; L = Ln;
    }
    while (!done) {
        const bool more_item = L + G < TOTAL; const int Ln = more_item ? L + G : L;
        const BlockRef nxt = more_item ? fox_ref(Ln, 0, T.JLO) : cur;
        fox_block<true>(cur, nxt, T, lds, S);
        if (!more_item) break;
        cur = nxt; L = Ln;
    }
}
#undef SBAR
#undef BR_Q
#undef BR_O
#undef BR_K
#undef BR_V
#undef BR_CK
#undef BR_CQ
}

namespace swa {
constexpr int NKMAX = 192, LDS_K = 0, LDS_V = NKMAX * 128, LDS_WS = 2 * NKMAX * 128, OST_OFF = 65536, LDS_BYTES = OST_OFF + 8 * 4096;
constexpr float C2 = 0.125f * 1.4426950408889634f, LOG2E = 1.4426950408889634f;
__device__ __forceinline__ int k_off(int row, int chunk) { return row * 128 + ((chunk ^ ((row >> 1) & 7)) << 4); }
__device__ __forceinline__ int v_st(int k, int c) { const int kk = (k & ~0xC) | ((k & 4) << 1) | ((k & 8) >> 1); return ((kk >> 3) * 2 + (c >> 5)) * 512 + ((kk & 7) * 32 + (c & 31)) * 2; }
__device__ __forceinline__ int v_rd_base(int lane) { return ((lane & 3) << 3) | (((lane >> 2) & 3) << 6) | (((lane >> 4) & 1) << 5) | (((lane >> 5) & 1) << 8); }
__device__ __forceinline__ int crow(int r, int hi) { return (r & 3) + 8 * (r >> 2) + 4 * hi; }
struct Tensors { const bf16* Q; const bf16* K; const bf16* V; bf16* O; const bf16* KSC; const bf16* VSC; const float* sinks; };
#define SWA_PK4(P, B_, OUT) do { unsigned a0 = cvtpk(P[B_+0], P[B_+1]), a1 = cvtpk(P[B_+2], P[B_+3]);                          \
        unsigned b0 = cvtpk(P[B_+4], P[B_+5]), b1 = cvtpk(P[B_+6], P[B_+7]);                                             \
        auto r0 = __builtin_amdgcn_permlane32_swap(a0, b0, false, false); auto r1 = __builtin_amdgcn_permlane32_swap(a1, b1, false, false); \
        v4u w = {r0[0], r1[0], r0[1], r1[1]}; OUT = *reinterpret_cast<bf16x8*>(&w); } while (0)
#define SWA_TRRD(dst, off) asm volatile("ds_read_b64_tr_b16 %0, %1 offset:%2" : "=&v"(dst) : "v"(vb0), "i"(off) : "memory")
template <int KB> __device__ __forceinline__ void pv_kb(f32x16* o, const f32x16& p, int vb0) {
    bf16x8 paL, paH; SWA_PK4(p, 0, paL); SWA_PK4(p, 8, paH);
#define SWA_PV_D0(d0) do { s16x4 l0, h0, l1, h1; constexpr int b_ = (d0) * 512 + (2 * KB) * 2048; \
        SWA_TRRD(l0, b_); SWA_TRRD(h0, b_ + 1024); SWA_TRRD(l1, b_ + 2048); SWA_TRRD(h1, b_ + 3072); \
        asm volatile("s_waitcnt lgkmcnt(0)" ::: "memory"); __builtin_amdgcn_sched_barrier(0); \
        o[d0] = __builtin_amdgcn_mfma_f32_32x32x16_bf16(paL, (bf16x8){l0[0], l0[1], l0[2], l0[3], h0[0], h0[1], h0[2], h0[3]}, o[d0], 0, 0, 0); \
        o[d0] = __builtin_amdgcn_mfma_f32_32x32x16_bf16(paH, (bf16x8){l1[0], l1[1], l1[2], l1[3], h1[0], h1[1], h1[2], h1[3]}, o[d0], 0, 0, 0); } while (0)
    SWA_PV_D0(0); SWA_PV_D0(1);
#undef SWA_PV_D0
}
__device__ __forceinline__ void swa_unit(int u, const Tensors& T, char* lds) {
    const int tid = fresh_tid(), wid = __builtin_amdgcn_readfirstlane(tid >> 6), lane = tid & 63, r32 = lane & 31, hi = lane >> 5;
    int ntok, NK, kvh; size_t qrow0; const bf16* Kp; const bf16* Vp;
    if (u < NB * (SEQ / 64) * SKV) { const int b = u / ((SEQ / 64) * SKV), rem = u % ((SEQ / 64) * SKV), c = rem >> 2; kvh = rem & 3;
        const int nprev = c < 2 ? c : 2; ntok = 64; NK = 64 * (nprev + 1); qrow0 = (size_t)b * SEQ + (size_t)c * 64;
        const size_t kr0 = qrow0 - 64 * nprev; Kp = T.K + kr0 * 256 + kvh * 64; Vp = T.V + kr0 * 256 + kvh * 64; }
    else { const int s = u - NB * (SEQ / 64) * SKV, b = s >> 2; kvh = s & 3; ntok = DECT; NK = SROWS; qrow0 = (size_t)MP + (size_t)b * DECT;
        Kp = T.KSC + (size_t)b * SROWS * 256 + kvh * 64; Vp = T.VSC + (size_t)b * SROWS * 256 + kvh * 64; }
    char* K_lds = lds + LDS_K; char* V_lds = lds + LDS_V; float* wsf = (float*)(lds + LDS_WS) + wid * 32;
#pragma unroll
    for (int i = 0; i < 3; ++i) { const int idx = tid + 512 * i, row = idx >> 3, ch = idx & 7;
        bf16x8 kv = {0, 0, 0, 0, 0, 0, 0, 0}, vv = {0, 0, 0, 0, 0, 0, 0, 0};
        if (row < NK) { kv = *(const bf16x8*)(Kp + (size_t)row * 256 + ch * 8); vv = *(const bf16x8*)(Vp + (size_t)row * 256 + ch * 8); }
        *(bf16x8*)(K_lds + k_off(row, ch)) = kv; *(bf16x8*)(V_lds + v_st(row, ch * 8)) = vv; }
    __syncthreads();
    const int vb0 = (int)(uintptr_t)V_lds + v_rd_base(lane);
    const int head = kvh * 8 + wid;
    const float sink2 = T.sinks[head] * LOG2E;
    for (int qb = 0; qb < ntok / 32; ++qb) {
        const bf16* qp = T.Q + (qrow0 + qb * 32 + r32) * DM + head * SHD + hi * 8;
        bf16x8 qf[4];
#pragma unroll
        for (int d0 = 0; d0 < 4; ++d0) qf[d0] = *(const bf16x8*)(qp + d0 * 16);
        f32x16 s[6];
#pragma unroll
        for (int kb = 0; kb < 6; ++kb) {
            if (kb * 32 < NK) {
                s[kb] = f32x16{};
#pragma unroll
                for (int d0 = 0; d0 < 4; ++d0) { const bf16x8 a = *(const bf16x8*)(K_lds + k_off(kb * 32 + r32, d0 * 2 + hi));
                    s[kb] = __builtin_amdgcn_mfma_f32_32x32x16_bf16(a, qf[d0], s[kb], 0, 0, 0); }
            } else {
#pragma unroll
                for (int r = 0; r < 16; ++r) s[kb][r] = -__builtin_inff();
            }
        }
        float mx = s[0][0];
#pragma unroll
        for (int kb = 0; kb < 6; ++kb)
#pragma unroll
            for (int r = 0; r < 16; ++r) mx = fmaxf(mx, s[kb][r]);
        { auto rr = __builtin_amdgcn_permlane32_swap(__float_as_uint(mx), __float_as_uint(mx), false, false); mx = fmaxf(__uint_as_float(rr[0]), __uint_as_float(rr[1])); }
        const float m2 = fmaxf(mx * C2, sink2);
        float ps = 0.f;
#pragma unroll
        for (int kb = 0; kb < 6; ++kb)
#pragma unroll
            for (int r = 0; r < 16; ++r) { const float p = __builtin_amdgcn_exp2f(fmaf(s[kb][r], C2, -m2)); s[kb][r] = p; ps += p; }
        { auto rr = __builtin_amdgcn_permlane32_swap(__float_as_uint(ps), __float_as_uint(ps), false, false); ps = __uint_as_float(rr[0]) + __uint_as_float(rr[1]); }
        const float den = ps + __builtin_amdgcn_exp2f(sink2 - m2);
        f32x16 o[2] = {};
        if (0 * 32 < NK) pv_kb<0>(o, s[0], vb0);
        if (1 * 32 < NK) pv_kb<1>(o, s[1], vb0);
        if (2 * 32 < NK) pv_kb<2>(o, s[2], vb0);
        if (3 * 32 < NK) pv_kb<3>(o, s[3], vb0);
        if (4 * 32 < NK) pv_kb<4>(o, s[4], vb0);
        if (5 * 32 < NK) pv_kb<5>(o, s[5], vb0);
        if (hi == 0) wsf[r32] = den; asm volatile("s_waitcnt lgkmcnt(0)" ::: "memory");
        bf16* Ow = T.O + (qrow0 + qb * 32) * DM + head * SHD; char* stg = lds + OST_OFF + wid * 4096;
#pragma unroll
        for (int r = 0; r < 16; ++r) { const int orow = crow(r, hi); const float rl = __builtin_amdgcn_rcpf(wsf[orow]);
#pragma unroll
            for (int d0 = 0; d0 < 2; ++d0) *(bf16*)(stg + orow * 128 + (d0 * 32 + r32) * 2) = (bf16)(cvtpk(o[d0][r] * rl, 0.f) & 0xffffu); }
        asm volatile("s_waitcnt lgkmcnt(0)" ::: "memory");
#pragma unroll
        for (int i = 0; i < 4; ++i) { const unsigned row = i * 8 + (lane >> 3); const v4u v = *(const v4u*)(stg + row * 128 + (lane & 7) * 16);
            *(v4u*)(Ow + (size_t)row * DM + (lane & 7) * 8) = v; }
        asm volatile("s_waitcnt lgkmcnt(0)" ::: "memory");
    }
    __syncthreads();
}
#undef SWA_PK4
#undef SWA_TRRD
__device__ __forceinline__ void swa_phase(char* lds, const Tensors& T, int vcu, int G) {
    constexpr int TOTAL = NB * (SEQ / 64) * SKV + DECB * SKV;
    for (int u = vcu; u < TOTAL; u += G) swa_unit(u, T, lds);
}
}

namespace sk {
constexpr int ROWB = 272;
constexpr int PART = 64 * ROWB;
constexpr int LDS_BYTES = 131072;
template <bool T> __device__ __forceinline__ size_t op_off(int row, int k, int K) { return T ? tiled_off(row, k, K) : ((size_t)row * K + k) * 2; }
template <int CB, bool AT, bool BT, class Epi>
__device__ __forceinline__ void sk_tile(const bf16* A, const bf16* Bt, int K, char* lds, const Epi& E, int grow0, int brow, int gcol0) {
    static_assert(!BT, "the weight operand of the skinny tiles is row-major");
    constexpr int NB = 2 * CB, BROUNDS = 2 * CB;
    constexpr int SBUF = 65536, SB_OFF = 32768;
    const int tid = fresh_tid(), wid = __builtin_amdgcn_readfirstlane(tid >> 6), lane = tid & 63, fr = lane & 15, fq = lane >> 4;
    const int nst = K >> 8;
    int lrow[4], lch[4]; size_t aoff[4];
#pragma unroll
    for (int j = 0; j < 4; ++j) {
        if (AT) { const int bb = tid * 16 + ((grow0 & 64) ? 8192 : 0), st = bb >> 10, sb = bb & 1023, swz = sb ^ (((sb >> 9) & 1) << 5), R = (st >> 1) * 16 + (swz >> 6), C = (st & 1) * 32 + ((swz & 63) >> 1);
            lrow[j] = R & 63; lch[j] = j * 8 + (C >> 3); aoff[j] = ((size_t)(grow0 >> 7) * (K >> 6) + j) * 16384 + bb; }
        else { const int idx = j * 512 + tid; lrow[j] = idx >> 5; lch[j] = idx & 31; aoff[j] = ((size_t)(grow0 + lrow[j]) * K + lch[j] * 8) * 2; }
    }
    const int brow_l = tid >> 5, bch = tid & 31;
    const char* Ab = (const char*)A; const char* Bb = (const char*)Bt + ((size_t)(brow + brow_l) * K + bch * 8) * 2;
    f32x4 acc[4][NB];
#pragma unroll
    for (int m = 0; m < 4; ++m)
#pragma unroll
        for (int n = 0; n < NB; ++n) acc[m][n] = (f32x4){0.f, 0.f, 0.f, 0.f};
    bf16x8 ra0[4], rb0[BROUNDS], ra1[4], rb1[BROUNDS], ra2[4], rb2[BROUNDS];
#define SK_GLOAD(ra, rb, s) do { if ((s) < nst) { _Pragma("unroll") for (int j = 0; j < 4; ++j) ra[j] = *(const bf16x8*)(Ab + aoff[j] + (size_t)(s) * (AT ? 65536 : 512)); \
        _Pragma("unroll") for (int j = 0; j < BROUNDS; ++j) rb[j] = *(const bf16x8*)(Bb + (size_t)(16 * j) * K * 2 + (size_t)(s) * 512); } } while (0)
#define SK_LWRITE(ra, rb, s) do { if ((s) < nst) { _Pragma("unroll") for (int j = 0; j < 4; ++j) *(bf16x8*)(lds + ((s) & 1) * SBUF + lrow[j] * 512 + ((lch[j] ^ (lrow[j] & 15)) << 4)) = ra[j]; \
        _Pragma("unroll") for (int j = 0; j < BROUNDS; ++j) *(bf16x8*)(lds + ((s) & 1) * SBUF + SB_OFF + (16 * j + brow_l) * 512 + ((bch ^ (brow_l & 15)) << 4)) = rb[j]; } } while (0)
    const int fo = fr * 512 + (((4 * wid + fq) ^ fr) << 4);
#define SK_COMPUTE(s) do { if ((s) < nst) { const char* sa = lds + ((s) & 1) * SBUF + fo; bf16x8 af[4], bfr[NB]; \
        _Pragma("unroll") for (int m = 0; m < 4; ++m) af[m] = *(const bf16x8*)(sa + m * 8192); \
        _Pragma("unroll") for (int n = 0; n < NB; ++n) bfr[n] = *(const bf16x8*)(sa + SB_OFF + n * 8192); \
        _Pragma("unroll") for (int m = 0; m < 4; ++m) _Pragma("unroll") for (int n = 0; n < NB; ++n) acc[m][n] = __builtin_amdgcn_mfma_f32_16x16x32_bf16(bfr[n], af[m], acc[m][n], 0, 0, 0); } } while (0)
    SK_GLOAD(ra0, rb0, 0); SK_GLOAD(ra1, rb1, 1);
    SK_LWRITE(ra0, rb0, 0); __syncthreads();
    for (int s = 0; s < nst; s += 3) {
        SK_GLOAD(ra2, rb2, s + 2); SK_COMPUTE(s);     SK_LWRITE(ra1, rb1, s + 1); __syncthreads();
        SK_GLOAD(ra0, rb0, s + 3); SK_COMPUTE(s + 1); SK_LWRITE(ra2, rb2, s + 2); __syncthreads();
        SK_GLOAD(ra1, rb1, s + 4); SK_COMPUTE(s + 2); SK_LWRITE(ra0, rb0, s + 3); __syncthreads();
    }
#undef SK_GLOAD
#undef SK_LWRITE
#undef SK_COMPUTE
    char* pw = lds + (wid & 3) * PART;
#define SK_AT(m, n) (pw + (16 * (m) + fr) * ROWB + (16 * (n) + 4 * fq) * 4)
    if (wid >= 4) {
#pragma unroll
        for (int m = 0; m < 4; ++m)
#pragma unroll
            for (int n = 0; n < NB; ++n) *(f32x4*)SK_AT(m, n) = acc[m][n]; }
    __syncthreads();
    if (wid < 4) {
#pragma unroll
        for (int m = 0; m < 4; ++m)
#pragma unroll
            for (int n = 0; n < NB; ++n) acc[m][n] += *(const f32x4*)SK_AT(m, n); }
    __syncthreads();
    if (wid < 4) {
#pragma unroll
        for (int m = 0; m < 4; ++m)
#pragma unroll
            for (int n = 0; n < NB; ++n) *(f32x4*)SK_AT(m, n) = acc[m][n]; }
    __syncthreads();
#undef SK_AT
    { const int row = tid >> 3, cg = (tid & 7) * 4 * CB; f32x4 v[CB];
#pragma unroll
        for (int c = 0; c < CB; ++c) { v[c] = *(const f32x4*)(lds + row * ROWB + (cg + 4 * c) * 4);
#pragma unroll
            for (int p = 1; p < 4; ++p) v[c] += *(const f32x4*)(lds + p * PART + row * ROWB + (cg + 4 * c) * 4); }
        E(grow0 + row, gcol0 + cg, v); }
    __syncthreads();
}
template <int CB, bool AT, bool BT, class Epi>
__device__ __forceinline__ void sk_gemm(const bf16* A, int row0, int nrt, const bf16* Bt, int brow0, int nct, int K, char* lds, const Epi& E, int vcu, int G, int rot = 0) {
    for (int t = (vcu + G - rot % G) % G; t < nrt * nct; t += G) { const int rt = t % nrt, ct = t / nrt;
        sk_tile<CB, AT, BT, Epi>(A, Bt, K, lds, E, row0 + 64 * rt, brow0 + 32 * CB * ct, 32 * CB * ct); }
}
__device__ __forceinline__ v4u pack8(f32x4 a, f32x4 b) { return (v4u){cvtpk(a[0], a[1]), cvtpk(a[2], a[3]), cvtpk(b[0], b[1]), cvtpk(b[2], b[3])}; }
struct SkFoxIn {
    bf16 *Q, *K, *V, *KC, *VC; float* out;
    __device__ __forceinline__ void operator()(int row, int col, const f32x4 (&v)[2]) const {
        const int kind = col >> 11, c = col & 2047, rs = row - MP, b = rs >> 5, t = rs & 31; const v4u w = pack8(v[0], v[1]);
        if (kind == 0) { *(v4u*)(Q + (size_t)row * DM + c) = w; }
        else { bf16* T = kind == 1 ? K : V; bf16* C = kind == 1 ? KC : VC; float* o = out + (kind == 1 ? O_FKS : O_FVS) + (size_t)rs * DM + c;
            *(v4u*)(T + (size_t)row * DM + c) = w; *(v4u*)(C + ((size_t)b * KCROWS + PAST + t) * DM + c) = w; *(f32x4*)o = v[0]; *(f32x4*)(o + 4) = v[1]; }
    }
};
struct SkGates {
    float* out; const float* bfg; float* lfh;
    __device__ __forceinline__ void operator()(int row, int col, const f32x4 (&v)[1]) const {
        if (col < FH) { const f32x4 b4 = *(const f32x4*)(bfg + col); f32x4 o;
#pragma unroll
            for (int e = 0; e < 4; ++e) { const float z = v[0][e] + b4[e]; o[e] = fminf(z, 0.f) - log1pf(__expf(-fabsf(z))); }
            float* dst = row < MP ? out + O_FLP + (size_t)row * FH : out + O_FLS + (size_t)(row - MP) * FH;
            *(f32x4*)(dst + col) = o;
            if (row < MP) { float* lp = lfh + ((size_t)(row >> 14) * FH + col) * SEQ + (row & (SEQ - 1));
#pragma unroll
                for (int e = 0; e < 4; ++e) lp[(size_t)e * SEQ] = o[e]; } }
    }
};
template <bool FUSE> struct SkResid {
    const float* base; float* X; const float* gate;
    const float* ng; const float* nsc; bf16* H; float* rss;
    __device__ __forceinline__ void operator()(int row, int col, const f32x4 (&v)[2]) const {
        const int rs = row - MP, ar = 2 + (rs >> 5); const float* gp = gate + (size_t)ar * ADAW + col; const float* bp = base + (size_t)rs * DM + col; float* xp = X + (size_t)rs * DM + col;
        const f32x4 g0 = *(const f32x4*)gp, g1 = *(const f32x4*)(gp + 4), b0 = *(const f32x4*)bp, b1 = *(const f32x4*)(bp + 4);
        const f32x4 x0 = b0 + g0 * v[0], x1 = b1 + g1 * v[1];
        *(f32x4*)xp = x0; *(f32x4*)(xp + 4) = x1;
        if (FUSE) { const float* sp = nsc + (size_t)ar * ADAW + col;
            const f32x4 c0 = *(const f32x4*)(ng + col) * (*(const f32x4*)sp + 1.0f), c1 = *(const f32x4*)(ng + col + 4) * (*(const f32x4*)(sp + 4) + 1.0f);
            *(v4u*)(H + (size_t)row * DM + col) = pack8(x0 * c0, x1 * c1);
            float ss = ((x0[0] * x0[0] + x0[1] * x0[1]) + (x0[2] * x0[2] + x0[3] * x0[3])) + ((x1[0] * x1[0] + x1[1] * x1[1]) + (x1[2] * x1[2] + x1[3] * x1[3]));
            ss += __shfl_xor(ss, 1); ss += __shfl_xor(ss, 2); ss += __shfl_xor(ss, 4);
            if ((col & 63) == 0) (void)__hip_atomic_fetch_add(rss + row, ss, __ATOMIC_RELAXED, __HIP_MEMORY_SCOPE_AGENT); }
    }
};
struct SkUp {
    bf16* Ah; const float* rss; const float* sw;
    __device__ __forceinline__ void operator()(int row, int col, const f32x4 (&v)[2]) const {
        const float rstd = 1.0f / sqrtf(rss[row] * (1.0f / DM) + RMS_EPS); const float* swp = sw + (size_t)(2 + ((row - MP) >> 5)) * DFF + col;
        f32x4 a = v[0] * rstd + *(const f32x4*)swp, b = v[1] * rstd + *(const f32x4*)(swp + 4);
#pragma unroll
        for (int e = 0; e < 4; ++e) { const float x = fmaxf(a[e], 0.f), y = fmaxf(b[e], 0.f); a[e] = x * x; b[e] = y * y; }
        *(v4u*)(Ah + (size_t)row * DFF + col) = pack8(a, b);
    }
};
struct SkSW {
    float* SW; int N;
    __device__ __forceinline__ void operator()(int row, int col, const f32x4 (&v)[2]) const {
        if (row < NADA) { float* o = SW + (size_t)row * N + col; *(f32x4*)o = v[0]; *(f32x4*)(o + 4) = v[1]; }
    }
};
struct SkSwaIn {
    bf16 *Q, *K, *V, *KSC, *VSC; float* out; const float* rope; const float* rss; const float* sw;
    __device__ __forceinline__ void operator()(int row, int col, const f32x4 (&vin)[2]) const {
        const int kind = col < DM ? 0 : (col < DM + 256 ? 1 : 2), rs = row - MP, b = rs >> 5, t = rs & 31;
        const float rstd = 1.0f / sqrtf(rss[row] * (1.0f / DM) + RMS_EPS); const float* swp = sw + (size_t)(2 + b) * SWA_IN + col;
        f32x4 v0 = vin[0] * rstd + *(const f32x4*)swp, v1 = vin[1] * rstd + *(const f32x4*)(swp + 4);
        { f32x4 p0, p1;
#pragma unroll
            for (int e = 0; e < 4; ++e) { p0[e] = __shfl_xor(v0[e], 1); p1[e] = __shfl_xor(v1[e], 1); }
            if (kind != 2 && (col & 63) < 16) { const float* rp = rope + (size_t)(PAST + t) * 16;
                const f32x4 c0 = *(const f32x4*)rp, c1 = *(const f32x4*)(rp + 4), s0 = *(const f32x4*)(rp + 8), s1 = *(const f32x4*)(rp + 12);
                if ((col & 8) == 0) { v0 = v0 * c0 - p0 * s0; v1 = v1 * c1 - p1 * s1; } else { v0 = v0 * c0 + p0 * s0; v1 = v1 * c1 + p1 * s1; } } }
        const v4u w = pack8(v0, v1);
        if (kind == 0) { *(v4u*)(Q + (size_t)row * DM + col) = w; }
        else { const int c = (col - DM) & 255; bf16* T = kind == 1 ? K : V; bf16* C = kind == 1 ? KSC : VSC; float* o = out + (kind == 1 ? O_SKS : O_SVS) + ((size_t)b * WBUF + (WBUF - DECT) + t) * 256 + c;
            *(v4u*)(T + (size_t)row * 256 + c) = w; *(v4u*)(C + ((size_t)b * SROWS + WBUF + t) * 256 + c) = w; *(f32x4*)o = v0; *(f32x4*)(o + 4) = v1; }
    }
};
}
#define XB_TMO      128
#define XB_XCNT(j)  (256  + 64 * (j))
#define XB_XSUB(j)  (1280 + 64 * (j))
#define XB_XGEN(j)  (2304 + 64 * (j))
#define XB_TOP      3328
#define XB_TOPGEN   3392
#define XCD_BAR_WORDS 3456
#define XB_SPIN_CAP (1u << 18)

__device__ __forceinline__ unsigned xb_ld(unsigned* p)              { return __hip_atomic_load(p, __ATOMIC_RELAXED, __HIP_MEMORY_SCOPE_AGENT); }
__device__ __forceinline__ unsigned xb_add(unsigned* p, unsigned v) { return __hip_atomic_fetch_add(p, v, __ATOMIC_RELAXED, __HIP_MEMORY_SCOPE_AGENT); }
__device__ __forceinline__ unsigned xb_xcc_id() { return (unsigned)__builtin_amdgcn_s_getreg((3 << 11) | 20) & 0xFu; }
#define XB_SPIN(cond, bar) do { unsigned _sp = 0; while (cond) { __builtin_amdgcn_s_sleep(1); \
    if ((++_sp & 255u) == 0u) { if (xb_ld(&(bar)[XB_TMO])) break; if (_sp > XB_SPIN_CAP) { atomicAdd(&(bar)[XB_TMO], 1u); break; } } } } while (0)

struct XcdBarrier {
    unsigned* bar; unsigned x;
    volatile LAS unsigned* st;
};

__device__ __forceinline__ XcdBarrier xcd_barrier_post(unsigned* bar, volatile LAS unsigned* st) {
    XcdBarrier b; b.bar = bar; b.x = xb_xcc_id(); b.st = st;
    if (threadIdx.x == 0) (void)xb_add(&bar[XB_XCNT(b.x)], 1u);
    return b;
}
__device__ __forceinline__ void xcd_barrier_complete(unsigned* bar, unsigned x, unsigned& nloc, unsigned& nx) {
    const unsigned G = gridDim.x * gridDim.y * gridDim.z;
    unsigned sum, cnt, mine, sp = 0u;
    for (;;) {
        sum = 0u; cnt = 0u; mine = 0u;
#pragma unroll
        for (unsigned j = 0; j < 16; ++j) { const unsigned c = xb_ld(&bar[XB_XCNT(j)]); sum += c; cnt += (c > 0u) ? 1u : 0u; mine = (j == x) ? c : mine; }
        if (sum == G) break;
        __builtin_amdgcn_s_sleep(1);
        if ((++sp & 255u) == 0u) { if (xb_ld(&bar[XB_TMO])) break; if (sp > XB_SPIN_CAP) { atomicAdd(&bar[XB_TMO], 1u); break; } }
    }
    nloc = mine > 0u ? mine : 1u; nx = cnt > 0u ? cnt : 1u;
}

__device__ __forceinline__ void xcd_barrier(const XcdBarrier& b) {
    asm volatile("s_waitcnt vmcnt(0)" ::: "memory");
    __syncthreads();
    if (threadIdx.x == 0) {
        unsigned* bar = b.bar;
        __builtin_amdgcn_s_waitcnt(0);
        unsigned nloc = b.st[0], nx = b.st[1];
        if (nloc == 0u) { xcd_barrier_complete(bar, b.x, nloc, nx); b.st[0] = nloc; b.st[1] = nx; }
        const unsigned old = xb_add(&bar[XB_XSUB(b.x)], 1u);
        const unsigned gen = old / nloc;
        if (old + 1u == (gen + 1u) * nloc) {
            __builtin_amdgcn_fence(__ATOMIC_RELEASE, "agent");
            asm volatile("s_waitcnt vmcnt(0)" ::: "memory");
            const unsigned og = xb_add(&bar[XB_TOP], 1u);
            const unsigned tg = og / nx;
            if (og + 1u == (tg + 1u) * nx) xb_add(&bar[XB_TOPGEN], 1u);
            else XB_SPIN(xb_ld(&bar[XB_TOPGEN]) == tg, bar);
            __builtin_amdgcn_fence(__ATOMIC_ACQUIRE, "agent");
            xb_add(&bar[XB_XGEN(b.x)], 1u);
            asm volatile("s_waitcnt vmcnt(0)" ::: "memory");
        } else {
            XB_SPIN(xb_ld(&bar[XB_XGEN(b.x)]) == gen, bar);
            __builtin_amdgcn_fence(__ATOMIC_ACQUIRE, "agent");
            asm volatile("s_waitcnt vmcnt(0)" ::: "memory");
        }
    }
    __syncthreads();
}

constexpr int NWAVES = 8;
constexpr int RING_OFF = 0, RING_BYTES = 131072, LDSCTL_OFF = RING_BYTES, MISC_OFF = LDSCTL_OFF + 320, LDS_BYTES = 147456;
static_assert(fox::LDS_BYTES <= RING_BYTES && swa::LDS_BYTES <= RING_BYTES && MISC_OFF + 128 <= LDS_BYTES, "LDS map");

struct Args { const float* in[22]; float* out; unsigned char* ws; int ph_lo, ph_hi, li, pad; };
struct Frame { int tid, lane, wave, vcu, G; };
typedef const __attribute__((address_space(4))) Args* KA;
__device__ __forceinline__ KA fresh_args() { KA p = (KA)__builtin_amdgcn_kernarg_segment_ptr(); asm volatile("" : "+s"(p)); return p; }

__device__ __forceinline__ float wave_sum(float v) {
#pragma unroll
    for (int o = 1; o < 64; o <<= 1) v += __shfl_xor(v, o);
    return v;
}

__device__ __forceinline__ void p0_transpose_item(const float* W, int K, int ldw, int nvalid, int nblk, bf16* WT, LAS float* scr, int item, int lane) {
    const int kb = item / nblk, nb = item % nblk, k0 = 64 * kb, n0 = 32 * nb;
    const int ncol = n0 + (lane & 31); const bool ok = ncol < nvalid;
    const float* wp = W + (size_t)(k0 + (lane >> 5)) * ldw + (ok ? ncol : 0);
#pragma unroll
    for (int h = 0; h < 2; ++h) {
        float t[16];
#pragma unroll
        for (int i = 0; i < 16; ++i) t[i] = wp[(size_t)(2 * (16 * h + i)) * ldw];
#pragma unroll
        for (int i = 0; i < 16; ++i) scr[(2 * (16 * h + i) + (lane >> 5)) * 33 + (lane & 31)] = ok ? t[i] : 0.f;
    }
    LDS_WAIT(); asm volatile("" ::: "memory");
    const int c = lane & 7;
#pragma unroll
    for (int j = 0; j < 4; ++j) { const int n = (lane >> 3) + 8 * j; const LAS float* s = scr + (8 * c) * 33 + n;
        v4u o; o.x = cvtpk(s[0 * 33], s[1 * 33]); o.y = cvtpk(s[2 * 33], s[3 * 33]); o.z = cvtpk(s[4 * 33], s[5 * 33]); o.w = cvtpk(s[6 * 33], s[7 * 33]);
        *(GAS v4u*)(WT + (size_t)(n0 + n) * K + k0 + 8 * c) = o; }
    LDS_WAIT(); asm volatile("" ::: "memory");
}
__device__ __forceinline__ void cvt_row_bf16(const float* src, bf16* dst, int lane) {
    const GAS f32x4* xr = (const GAS f32x4*)src + lane; GAS v2u* o8 = (GAS v2u*)dst + lane;
    f32x4 v[8];
#pragma unroll
    for (int j = 0; j < 8; ++j) v[j] = xr[64 * j];
#pragma unroll
    for (int j = 0; j < 8; ++j) { v2u w; w.x = cvtpk(v[j][0], v[j][1]); w.y = cvtpk(v[j][2], v[j][3]); o8[64 * j] = w; }
}
__device__ __forceinline__ void sincos_d(double a, double& s, double& c) {
    const double n = __builtin_rint(a * 0.6366197723675814);
    double r = __builtin_fma(-n, 1.5707963267948966, a); r = __builtin_fma(-n, 6.123233995736766e-17, r);
    const double r2 = r * r;
    double ps = -7.6471637318198164759e-13; ps = ps * r2 + 1.6059043836821614599e-10; ps = ps * r2 - 2.5052108385441718775e-8; ps = ps * r2 + 2.7557319223985890653e-6;
    ps = ps * r2 - 1.9841269841269841270e-4; ps = ps * r2 + 8.3333333333333333333e-3; ps = ps * r2 - 1.6666666666666666667e-1; ps = r + r * r2 * ps;
    double pc = 4.7794773323873852974e-14; pc = pc * r2 - 1.1470745597729724714e-11; pc = pc * r2 + 2.0876756987868098979e-9; pc = pc * r2 - 2.7557319223985890653e-7;
    pc = pc * r2 + 2.4801587301587301587e-5; pc = pc * r2 - 1.3888888888888888889e-3; pc = pc * r2 + 4.1666666666666666667e-2; pc = pc * r2 - 0.5; pc = 1.0 + r2 * pc;
    const int q = (int)n & 3;
    s = (q == 0) ? ps : (q == 1) ? pc : (q == 2) ? -ps : -pc;
    c = (q == 0) ? pc : (q == 1) ? -ps : (q == 2) ? -pc : ps;
}

__device__ __forceinline__ void p0_ada(KA a, const Frame& F, LAS unsigned char* lds) {
    LAS float* sS = (LAS float*)lds;
    LAS float* red = (LAS float*)(lds + 36864);
    const float* cP = a->in[2]; const float* cS = a->in[3]; const float* W = a->in[9]; const float* Bv = a->in[10];
    float* ADA = (float*)(a->ws + WS_ADA);
    const int half = F.lane >> 5, cl = (F.lane & 31) * 4;
    for (int task = F.vcu; task < 2 * (ADAW / 128); task += F.G) {
        const int l = task / (ADAW / 128), n0 = (task % (ADAW / 128)) * 128;
        const float* Wl = W + (size_t)l * DM * ADAW + n0 + cl;
        f32x4 acc[NADA];
#pragma unroll
        for (int r = 0; r < NADA; ++r) acc[r] = (f32x4){0.f, 0.f, 0.f, 0.f};
        for (int stage = 0; stage < 4; ++stage) {
            __syncthreads();
            for (int idx = F.tid; idx < NADA * 512; idx += NWAVES * 64) { const int r = idx >> 9, k = idx & 511;
                const float cv = r < 2 ? cP[r * DM + stage * 512 + k] : cS[(r - 2) * DM + stage * 512 + k];
                sS[idx] = cv / (1.f + __expf(-cv)); }
            __syncthreads();
            const int kw = F.wave * 64;
#pragma unroll 1
            for (int i0 = 0; i0 < 32; i0 += 8) {
                f32x4 wv[8];
#pragma unroll
                for (int i = 0; i < 8; ++i) wv[i] = *(const f32x4*)(Wl + (size_t)(stage * 512 + kw + 2 * (i0 + i) + half) * ADAW);
#pragma unroll
                for (int i = 0; i < 8; ++i) { const int k = kw + 2 * (i0 + i) + half;
#pragma unroll
                    for (int r = 0; r < NADA; ++r) acc[r] += wv[i] * sS[r * 512 + k]; }
            }
        }
#pragma unroll
        for (int hh = 0; hh < 2; ++hh) {
            __syncthreads();
#pragma unroll
            for (int r = 0; r < 9; ++r) *(LAS f32x4*)(red + ((F.wave * 2 + half) * 9 + r) * 128 + cl) = acc[9 * hh + r];
            __syncthreads();
            for (int idx = F.tid; idx < 9 * 128; idx += NWAVES * 64) { const int r = idx >> 7, c = idx & 127; float s = 0.f;
#pragma unroll
                for (int p = 0; p < 16; ++p) s += red[(p * 9 + r) * 128 + c];
                ADA[((size_t)l * NADA + 9 * hh + r) * ADAW + n0 + c] = s + Bv[(size_t)l * ADAW + n0 + c]; }
        }
    }
    __syncthreads();
}

constexpr int I_FIN = 32 * (FOX_IN_PAD / 32), I_SQ = 32 * 64, I_SIN = 32 * (SWA_IN / 32), I_UP = 32 * (DFF / 32), I_DN = (DFF / 64) * 64;
constexpr int NITEMS = I_FIN + 2 * I_SQ + I_SIN + 2 * I_UP + 2 * I_DN;
__device__ __forceinline__ void p0_copies(KA a, LAS unsigned char* lds, int wave, int lane, int first, int it0, int it1, int gw, int NGW, bool caches) {
    unsigned char* ws = a->ws;
    LAS float* scr = (LAS float*)(lds + wave * 16384);
    for (int it = it0 + first; it < it1; it += NGW) {
        int r = it;
        if (r < I_FIN) { p0_transpose_item(a->in[13], DM, FOX_IN, FOX_IN, FOX_IN_PAD / 32, (bf16*)(ws + WS_WFIN), scr, r, lane); continue; } r -= I_FIN;
        if (r < I_SQ) { p0_transpose_item(a->in[15], DM, DM, DM, 64, (bf16*)(ws + WS_WFOUT), scr, r, lane); continue; } r -= I_SQ;
        if (r < I_SIN) { p0_transpose_item(a->in[16], DM, SWA_IN, SWA_IN, SWA_IN / 32, (bf16*)(ws + WS_WSIN), scr, r, lane); continue; } r -= I_SIN;
        if (r < I_SQ) { p0_transpose_item(a->in[18], DM, DM, DM, 64, (bf16*)(ws + WS_WSOUT), scr, r, lane); continue; } r -= I_SQ;
        if (r < 2 * I_UP) { const int l = r / I_UP; p0_transpose_item(a->in[19] + (size_t)l * DM * DFF, DM, DFF, DFF, DFF / 32, (bf16*)(ws + WS_WUP) + (size_t)l * DM * DFF, scr, r % I_UP, lane); continue; } r -= 2 * I_UP;
        { const int l = r / I_DN; p0_transpose_item(a->in[20] + (size_t)l * DM * DFF, DFF, DM, DM, 64, (bf16*)(ws + WS_WDN) + (size_t)l * DM * DFF, scr, r % I_DN, lane); }
    }
    if (caches) for (int it = gw; it < 2 * DECB * KCROWS; it += NGW) {
        const int kv = it / (DECB * KCROWS), rem = it % (DECB * KCROWS), b = rem / KCROWS, p = rem % KCROWS;
        bf16* dst = (bf16*)(ws + (kv ? WS_VC : WS_KC)) + ((size_t)b * KCROWS + p) * DM;
        if (p < PAST) cvt_row_bf16(a->in[kv ? 5 : 4] + ((size_t)b * PAST + p) * DM, dst, lane);
        else if (p >= PAST + DECT) { GAS v2u* o8 = (GAS v2u*)dst + lane;
#pragma unroll
            for (int j = 0; j < 8; ++j) o8[64 * j] = (v2u){0u, 0u}; }
    }
}
constexpr int NWORK = 4;
__device__ __forceinline__ void p0_prologue(KA a, const Frame& F, LAS unsigned char* lds) {
    unsigned char* ws = a->ws;
    p0_ada(a, F, lds);
    const int gw = F.vcu * NWAVES + F.wave, NGW = F.G * NWAVES;
    const int irot = NGW > 2 * (ADAW / 128) * NWAVES ? 2 * (ADAW / 128) * NWAVES : 0;
    const bool split = (F.G % 8 == 0) && (F.G / 8 > NWORK);
    p0_copies(a, lds, F.wave, F.lane, (gw + NGW - irot) % NGW, 0, split ? I_FIN : NITEMS, gw, NGW, !split);
    const int gt = (F.vcu * NWAVES + F.wave) * 64 + F.lane, NGT = NGW * 64;
    float* rope = (float*)(ws + WS_ROPE);
    for (int e = gt; e < SEQ * 8; e += NGT) { const int pos = e >> 3, i = e & 7;
        const double inv = i == 0 ? 1.0 : i == 1 ? 0.19392274474868576 : i == 2 ? 0.03760603093086393 : i == 3 ? 0.007292664737217109 : i == 4 ? 0.001414213562373095 :
                           i == 5 ? 0.0002742481756762073 : i == 6 ? 5.318295896944988e-05 : 1.031338537721246e-05;
        double s, c; sincos_d((double)pos * inv, s, c); rope[pos * 16 + i] = (float)c; rope[pos * 16 + 8 + i] = (float)s; }
    for (int e = gt; e < 2 * DECB * WBUF * 256; e += NGT) { const int kv = e / (DECB * WBUF * 256), rem = e % (DECB * WBUF * 256), b = rem / (WBUF * 256), p = (rem / 256) % WBUF, c = rem & 255;
        const float v = a->in[kv ? 8 : 7][rem];
        ((bf16*)(ws + (kv ? WS_VSC : WS_KSC)))[((size_t)b * SROWS + p) * 256 + c] = (bf16)(cvtpk(v, 0.f) & 0xffffu);
        if (p >= DECT) a->out[(kv ? O_SVS : O_SKS) + ((size_t)b * WBUF + (p - DECT)) * 256 + c] = v; }
}

__device__ __forceinline__ void norm_rows(const float* xP, const float* xS, const float* g, const float* ada_l, int shift_idx, bf16* H, const Frame& F) {
    const int gw = F.vcu * NWAVES + F.wave, NGW = F.G * NWAVES;
    for (int blk = gw; blk < MP / 16 + MS; blk += NGW) {
        const int row0 = blk < MP / 16 ? blk * 16 : MP + (blk - MP / 16), nrows = blk < MP / 16 ? 16 : 1;
        const float* ap = ada_l + (size_t)arow_of(row0) * ADAW + shift_idx * DM;
        f32x4 mul[8], add[8];
#pragma unroll
        for (int j = 0; j < 8; ++j) { const int c = 4 * F.lane + 256 * j; const f32x4 gv = *(const f32x4*)(g + c), sc = *(const f32x4*)(ap + DM + c); add[j] = *(const f32x4*)(ap + c); mul[j] = gv * (sc + 1.0f); }
        for (int rr = 0; rr < nrows; ++rr) { const int row = row0 + rr;
            const GAS f32x4* xr = (const GAS f32x4*)(row < MP ? xP + (size_t)row * DM : xS + (size_t)(row - MP) * DM) + F.lane;
            f32x4 v[8]; float ss = 0.f;
#pragma unroll
            for (int j = 0; j < 8; ++j) { v[j] = xr[64 * j]; ss += (v[j][0] * v[j][0] + v[j][1] * v[j][1]) + (v[j][2] * v[j][2] + v[j][3] * v[j][3]); }
            const float rstd = 1.0f / sqrtf(wave_sum(ss) * (1.0f / DM) + RMS_EPS);
            const size_t o0 = ((size_t)row * DM + 4 * F.lane) * 2;
#pragma unroll
            for (int j = 0; j < 8; ++j) { const f32x4 h = (v[j] * rstd) * mul[j] + add[j]; v2u w; w.x = cvtpk(h[0], h[1]); w.y = cvtpk(h[2], h[3]); *(GAS v2u*)((GAS char*)H + o0 + (size_t)j * 512) = w; }
        }
    }
}
__device__ __forceinline__ void fill_shift_rows(const float* ADA, bf16* SH, const Frame& F) {
    const int gt = (F.vcu * NWAVES + F.wave) * 64 + F.lane, NGT = F.G * NWAVES * 64;
    for (int e = gt; e < 3 * 64 * DM; e += NGT) { const int c = e / (64 * DM), r = (e / DM) & 63, k = e & (DM - 1);
        const float* sh = ADA + (c == 0 ? 3 * DM : (c == 1 ? NADA * ADAW : NADA * ADAW + 3 * DM));
        SH[e] = r < NADA ? (bf16)(cvtpk(sh[(size_t)r * ADAW + k], 0.f) & 0xffffu) : (bf16)0; }
}
__device__ __forceinline__ void final_norm(float* X, const float* g, const Frame& F) {
    const int gw = F.vcu * NWAVES + F.wave, NGW = F.G * NWAVES;
    f32x4 gv[8];
#pragma unroll
    for (int j = 0; j < 8; ++j) gv[j] = *(const f32x4*)(g + 4 * F.lane + 256 * j);
    for (int row = gw; row < MT; row += NGW) {
        GAS f32x4* xr = (GAS f32x4*)(X + (size_t)row * DM) + F.lane;
        f32x4 v[8]; float ss = 0.f;
#pragma unroll
        for (int j = 0; j < 8; ++j) { v[j] = xr[64 * j]; ss += (v[j][0] * v[j][0] + v[j][1] * v[j][1]) + (v[j][2] * v[j][2] + v[j][3] * v[j][3]); }
        const float rstd = 1.0f / sqrtf(wave_sum(ss) * (1.0f / DM) + RMS_EPS);
#pragma unroll
        for (int j = 0; j < 8; ++j) xr[64 * j] = (v[j] * rstd) * gv[j];
    }
}
__device__ __forceinline__ void bias_rows(float x, bf16* ck, bf16* cq) {
    const unsigned c1 = cvtpk(x, 0.f) & 0xffffu; const float r1 = x - __uint_as_float(c1 << 16);
    const unsigned c2 = cvtpk(r1, 0.f) & 0xffffu; const float r2 = r1 - __uint_as_float(c2 << 16);
    const unsigned c3 = cvtpk(r2, 0.f) & 0xffffu;
    const unsigned one = 0x3F80u;
    *(GAS v4u*)ck = (v4u){(c1 ^ 0x8000u) | ((c2 ^ 0x8000u) << 16), (c3 ^ 0x8000u) | (one << 16), one | (one << 16), 0u};
    *(GAS v4u*)cq = (v4u){one | (one << 16), one | (c1 << 16), c2 | (c3 << 16), 0u};
}
__device__ __forceinline__ void fox_norms(const bf16* Q, const bf16* K, float* QN, float* KN, float* SD, const Frame& F) {
    const int gw = F.vcu * NWAVES + F.wave, NGW = F.G * NWAVES;
    for (int row = gw; row < MP; row += NGW) {
        const GAS v4u* qp = (const GAS v4u*)(Q + (size_t)row * DM) + 4 * F.lane; const GAS v4u* kp = (const GAS v4u*)(K + (size_t)row * DM) + 4 * F.lane;
        v4u qv[4], kv[4];
#pragma unroll
        for (int j = 0; j < 4; ++j) { qv[j] = qp[j]; kv[j] = kp[j]; }
        float qq = 0.f, kk = 0.f, qk = 0.f;
#pragma unroll
        for (int j = 0; j < 4; ++j)
#pragma unroll
            for (int e = 0; e < 4; ++e) { const float q0 = __uint_as_float(qv[j][e] << 16), q1 = __uint_as_float(qv[j][e] & 0xffff0000u), k0 = __uint_as_float(kv[j][e] << 16), k1 = __uint_as_float(kv[j][e] & 0xffff0000u);
                qq += q0 * q0 + q1 * q1; kk += k0 * k0 + k1 * k1; qk += q0 * k0 + q1 * k1; }
        qq += __shfl_xor(qq, 1); kk += __shfl_xor(kk, 1); qk += __shfl_xor(qk, 1);
        qq += __shfl_xor(qq, 2); kk += __shfl_xor(kk, 2); qk += __shfl_xor(qk, 2);
        if ((F.lane & 3) == 0) { const size_t ix = ((size_t)(row >> 14) * FH + (F.lane >> 2)) * SEQ + (row & (SEQ - 1)); QN[ix] = qq; KN[ix] = kk; SD[ix] = qk * 0.08838834764831845f; }
    }
}
constexpr float PRUNE_EPS = 2.9802322e-8f;
__device__ __forceinline__ void fox_scan(KA a, const Frame& F, LAS unsigned char* lds) {
    LAS double* sd = (LAS double*)lds;
    LAS float* s_cend = (LAS float*)(lds + 8192);
    LAS float* s_kpre = (LAS float*)(lds + 10240);
    LAS float* s_qmax = (LAS float*)(lds + 14336);
    LAS float* s_sdmin = (LAS float*)(lds + 16384);
    LAS float* stg = (LAS float*)(lds + 20480);
    const float* QN = (const float*)(a->ws + WS_QN); const float* KN = (const float*)(a->ws + WS_KN); const float* SD = (const float*)(a->ws + WS_SD); const float* LFH = (const float*)(a->ws + WS_LFH);
    int* JLO = (int*)(a->ws + WS_JLO);
    const float* lsm = a->out + O_FLS; const float* lc = a->in[6];
    const int tid = F.tid;
    for (int task = F.vcu; task < NB * FH + DECB * FH; task += F.G) {
        if (task < NB * FH) {
            const int s = task; const size_t sb = (size_t)s * SEQ;
            bf16* dk = (bf16*)(a->ws + WS_CKP) + sb * 8; bf16* dq = (bf16*)(a->ws + WS_CQP) + sb * 8;
#define SCAN_STAGE(SRC) do { __syncthreads(); f32x4 t_[8]; _Pragma("unroll") for (int k = 0; k < 8; ++k) t_[k] = *(const f32x4*)((SRC) + sb + (size_t)(k * 512 + tid) * 4); \
            _Pragma("unroll") for (int k = 0; k < 8; ++k) { const int p = (k * 512 + tid) * 4, q_ = p + (p >> 5); stg[q_] = t_[k][0]; stg[q_ + 1] = t_[k][1]; stg[q_ + 2] = t_[k][2]; stg[q_ + 3] = t_[k][3]; } __syncthreads(); } while (0)
            float kmx = 0.f, qmx = 0.f, sdm = 3.0e38f; double loc = 0.0;
            SCAN_STAGE(KN);
#pragma unroll 8
            for (int i = 0; i < 32; ++i) kmx = fmaxf(kmx, stg[33 * tid + i]);
            SCAN_STAGE(QN);
#pragma unroll 8
            for (int i = 0; i < 32; ++i) qmx = fmaxf(qmx, stg[33 * tid + i]);
            SCAN_STAGE(SD);
#pragma unroll 8
            for (int i = 0; i < 32; ++i) sdm = fminf(sdm, stg[33 * tid + i]);
            SCAN_STAGE(LFH);
#pragma unroll 8
            for (int i = 0; i < 32; ++i) loc += (double)stg[33 * tid + i];
#undef SCAN_STAGE
            sd[tid] = loc; __syncthreads();
            int cur = 0;
            for (int off = 1; off < 512; off <<= 1) { const double v = sd[cur * 512 + tid] + (tid >= off ? sd[cur * 512 + tid - off] : 0.0); sd[(cur ^ 1) * 512 + tid] = v; cur ^= 1; __syncthreads(); }
            double run = sd[cur * 512 + tid] - loc;
#pragma unroll 8
            for (int i = 0; i < 32; ++i) { run += (double)stg[33 * tid + i]; stg[33 * tid + i] = (float)(run * 11.313708498984761); }
            s_cend[tid] = (float)run; s_qmax[tid] = qmx; s_sdmin[tid] = sdm; s_kpre[tid] = kmx; __syncthreads();
            for (int k = 0; k < 32; ++k) { const int p = k * 512 + tid; bias_rows(stg[p + (p >> 5)], dk + (size_t)p * 8, dq + (size_t)p * 8); }
            if (tid < SEQ / 256) { const int qb = tid; int jlo = 0;
                if (qb > 0) { float q2 = 0.f, ml = 3.0e38f;
                    for (int i = 0; i < 8; ++i) { q2 = fmaxf(q2, s_qmax[8 * qb + i]); ml = fminf(ml, s_sdmin[8 * qb + i]); }
                    const float cq = s_cend[8 * qb - 1]; float S = 0.f;
                    for (int j = 0; j < 4 * qb; ++j) { const float U = 1.001f * 0.08838834764831845f * sqrtf(q2 * fmaxf(s_kpre[2 * j], s_kpre[2 * j + 1])) + (cq - s_cend[2 * j + 1]);
                        S += 64.64f * __expf(fminf(U - ml, 0.f));
                        if (S > PRUNE_EPS) break;
                        jlo = j + 1; } }
                JLO[s * (SEQ / 256) + qb] = jlo; }
        } else {
            const int s = task - NB * FH, b = s >> 4, h = s & 15; constexpr int L = PAST + DECT, per = 3;
            bf16* dk = (bf16*)(a->ws + WS_CKS) + (size_t)s * KCROWS * 8; bf16* dq = (bf16*)(a->ws + WS_CQS) + (size_t)s * KCROWS * 8;
            const int p0 = tid * per, p1 = (p0 + per < L) ? p0 + per : L;
            double loc = 0.0;
            for (int p = p0; p < p1; ++p) { const float v = p < PAST ? lc[((size_t)b * PAST + p) * FH + h] : lsm[((size_t)b * DECT + (p - PAST)) * FH + h]; loc += (double)v; }
            __syncthreads();
            sd[tid] = loc; __syncthreads();
            int cur = 0;
            for (int off = 1; off < 512; off <<= 1) { const double v = sd[cur * 512 + tid] + (tid >= off ? sd[cur * 512 + tid - off] : 0.0); sd[(cur ^ 1) * 512 + tid] = v; cur ^= 1; __syncthreads(); }
            double run = sd[cur * 512 + tid] - loc;
            for (int p = p0; p < p1; ++p) { const float v = p < PAST ? lc[((size_t)b * PAST + p) * FH + h] : lsm[((size_t)b * DECT + (p - PAST)) * FH + h]; run += (double)v;
                bias_rows((float)(run * 11.313708498984761), dk + (size_t)p * 8, dq + (size_t)p * 8); }
            const double tot = sd[cur * 512 + 511]; if (tid < KCROWS - (PAST + DECT)) bias_rows((float)(tot * 11.313708498984761), dk + (size_t)(PAST + DECT + tid) * 8, dq + (size_t)(PAST + DECT + tid) * 8);
        }
    }
    __syncthreads();
}

#ifndef MK_N_LAUNCHES
#define MK_N_LAUNCHES 1
#endif
constexpr int N_PHASES = 18;
constexpr bool ONE_LAUNCH = (MK_N_LAUNCHES == 1);

__global__ void __launch_bounds__(NWAVES * 64, 2) mk_fwd(Args args) {
    extern __shared__ __attribute__((aligned(16))) unsigned char lds[];
    LAS unsigned char* ldsl = (LAS unsigned char*)lds;
    volatile LAS unsigned* MISC = (volatile LAS unsigned*)(ldsl + MISC_OFF);
    gu32* ctl = (gu32*)(args.ws + WS_CTL);
    for (int u = fresh_tid(); u < (LDS_BYTES - LDSCTL_OFF) / 4; u += NWAVES * 64) ((LAS unsigned*)(ldsl + LDSCTL_OFF))[u] = 0u;
    __syncthreads();
    XcdBarrier bar; bar.bar = (unsigned*)(ctl + CW_BAR); bar.x = 0; bar.st = nullptr;
    if (ONE_LAUNCH) bar = xcd_barrier_post((unsigned*)(ctl + CW_BAR), MISC + 8);
#define GRID_BAR() do { if (ONE_LAUNCH) xcd_barrier(bar); } while (0)
    const int lo = args.ph_lo, hi = args.ph_hi;
#ifdef PHASE_MASK
#define IN(k) (((PHASE_MASK >> (k)) & 1) && lo <= (k) && (k) < hi)
#else
#define IN(k) (lo <= (k) && (k) < hi)
#endif
#define BOTH(k) (IN(k) && IN((k) + 1))
#define MKFRAME Frame F; { const int t_ = fresh_tid(); F.tid = t_; F.lane = t_ & 63; F.wave = __builtin_amdgcn_readfirstlane(t_ >> 6); F.G = gridDim.x; const int bx = blockIdx.x; F.vcu = (F.G % 8 == 0) ? (bx % 8) * (F.G / 8) + bx / 8 : bx; }
#define PHASE_PTRS MKFRAME; KA A = fresh_args(); unsigned char* ws = A->ws; float* out = A->out; float* X = out + O_Y; float* ADA = (float*)(ws + WS_ADA); const float* ADA1 = ADA + (size_t)NADA * ADAW; \
    bf16* Hb = (bf16*)(ws + WS_H); bf16* Qb = (bf16*)(ws + WS_Q); bf16* Kb = (bf16*)(ws + WS_K); bf16* Vb = (bf16*)(ws + WS_V); bf16* Ob = (bf16*)(ws + WS_O); bf16* Ab = (bf16*)(ws + WS_A); \
    float* RSS = (float*)(ws + WS_CTL + CTL_RSS); bf16* SH = (bf16*)(ws + WS_SH); (void)RSS; (void)SH; (void)X; (void)ADA; (void)ADA1; (void)Hb; (void)Qb; (void)Kb; (void)Vb; (void)Ob; (void)Ab; (void)out

    if (IN(0)) { MKFRAME; p0_prologue(fresh_args(), F, ldsl); if (BOTH(0)) GRID_BAR(); }
    if (IN(1)) { PHASE_PTRS; norm_rows(A->in[0], A->in[1], A->in[11], ADA, 0, Hb, F); fill_shift_rows(ADA, SH, F); if (BOTH(1)) GRID_BAR(); }
    if (IN(2)) { PHASE_PTRS;
        { const int c = (int)blockIdx.x;
          if ((F.G % 8 == 0) && (F.G / 8 > NWORK) && (c >> 3) < NWORK) { const int wgw = ((c & 7) * NWORK + (c >> 3)) * NWAVES + F.wave;
              p0_copies(A, ldsl, F.wave, F.lane, wgw, I_FIN, NITEMS, wgw, 8 * NWORK * NWAVES, true); __syncthreads(); } }
        pg8::Gemm g{Hb, (const bf16*)(ws + WS_WFIN), MP, 3 * DM, DM};
        pg8::DynOrder S; S.init(MP, 3 * DM, (int)blockIdx.x, (unsigned*)(ws + WS_CTL) + CW_DYN, (int)(uintptr_t)(LAS char*)(MISC + 16));
        pg8::EpiFoxIn E{Qb, (size_t)(WS_K - WS_Q) / 2, out};
        pg8::gemm_phase<pg8::EpiFoxIn, pg8::DynOrder, true, true>(ldsl + RING_OFF, g, S, E);
        { const sk::SkFoxIn Es{Qb, Kb, Vb, (bf16*)(ws + WS_KC), (bf16*)(ws + WS_VC), out};
          sk::sk_gemm<2, false, false, sk::SkFoxIn>(Hb, MP, MS / 64, (const bf16*)(ws + WS_WFIN), 0, 3 * DM / 64, DM, (char*)lds + RING_OFF, Es, F.vcu, F.G);
          const sk::SkGates Eg{out, A->in[14], (float*)(ws + WS_LFH)};
          sk::sk_gemm<1, false, false, sk::SkGates>(Hb, 0, MT / 64, (const bf16*)(ws + WS_WFIN), 3 * DM, 1, DM, (char*)lds + RING_OFF, Eg, F.vcu, F.G, 248); }
        if (BOTH(2)) GRID_BAR();
    }
    if (IN(3)) { PHASE_PTRS; fox_norms(Qb, Kb, (float*)(ws + WS_QN), (float*)(ws + WS_KN), (float*)(ws + WS_SD), F); if (BOTH(3)) GRID_BAR(); }
    if (IN(4)) { MKFRAME; fox_scan(fresh_args(), F, ldsl); if (BOTH(4)) GRID_BAR(); }
    if (IN(5)) { PHASE_PTRS;
        const fox::Tensors T{Qb, Kb, Vb, Ob, (const bf16*)(ws + WS_KC), (const bf16*)(ws + WS_VC), (const bf16*)(ws + WS_CKP), (const bf16*)(ws + WS_CQP), (const bf16*)(ws + WS_CKS), (const bf16*)(ws + WS_CQS), (const int*)(ws + WS_JLO)};
        fox::fox_phase((char*)lds + RING_OFF, T, F.vcu, F.G);
        if (BOTH(5)) GRID_BAR();
    }
    if (IN(6)) { PHASE_PTRS;
        pg8::Gemm g{Ob, (const bf16*)(ws + WS_WFOUT), MP, DM, DM}; pg8::StaticOrder S; S.init(MP, DM, F.G, (int)blockIdx.x);
        pg8::EpiResid<true> E{A->in[0], X, ADA + 2 * DM, A->in[12], ADA + 4 * DM, Hb, RSS};
        pg8::gemm_phase<pg8::EpiResid<true>, pg8::StaticOrder, true, true>(ldsl + RING_OFF, g, S, E);
        { const sk::SkResid<true> Es{A->in[1], X + (size_t)MP * DM, ADA + 2 * DM, A->in[12], ADA + 4 * DM, Hb, RSS};
          sk::sk_gemm<2, false, false, sk::SkResid<true>>(Ob, MP, MS / 64, (const bf16*)(ws + WS_WFOUT), 0, DM / 64, DM, (char*)lds + RING_OFF, Es, F.vcu, F.G); }
        { const sk::SkSW E0{(float*)(ws + WS_SW0), DFF}, E1{(float*)(ws + WS_SW1), SWA_IN}, E2{(float*)(ws + WS_SW2), DFF};
          sk::sk_gemm<2, false, false, sk::SkSW>(SH, 0, 1, (const bf16*)(ws + WS_WUP), 0, DFF / 64, DM, (char*)lds + RING_OFF, E0, F.vcu, F.G, 128);
          sk::sk_gemm<2, false, false, sk::SkSW>(SH + 64 * DM, 0, 1, (const bf16*)(ws + WS_WSIN), 0, SWA_IN / 64, DM, (char*)lds + RING_OFF, E1, F.vcu, F.G, 128);
          sk::sk_gemm<2, false, false, sk::SkSW>(SH + 2 * 64 * DM, 0, 1, (const bf16*)(ws + WS_WUP) + (size_t)DM * DFF, 0, DFF / 64, DM, (char*)lds + RING_OFF, E2, F.vcu, F.G); }
        if (BOTH(6)) GRID_BAR();
    }
    if (IN(8)) { PHASE_PTRS;
        pg8::Gemm g{Hb, (const bf16*)(ws + WS_WUP), MP, DFF, DM}; pg8::StaticOrder S; S.init(MP, DFF, F.G, (int)blockIdx.x);
        pg8::EpiUp E{Ab, RSS, (const float*)(ws + WS_SW0)};
        pg8::gemm_phase<pg8::EpiUp, pg8::StaticOrder, true, true>(ldsl + RING_OFF, g, S, E);
        { const sk::SkUp Es{Ab, RSS, (const float*)(ws + WS_SW0)}; sk::sk_gemm<2, false, false, sk::SkUp>(Hb, MP, MS / 64, (const bf16*)(ws + WS_WUP), 0, DFF / 64, DM, (char*)lds + RING_OFF, Es, F.vcu, F.G); }
        if (BOTH(8)) GRID_BAR();
    }
    if (IN(9)) { PHASE_PTRS;
        pg8::Gemm g{Ab, (const bf16*)(ws + WS_WDN), MP, DM, DFF}; pg8::StaticOrder S; S.init(MP, DM, F.G, (int)blockIdx.x);
        pg8::EpiResid<true> E{X, X, ADA + 5 * DM, A->in[11] + DM, ADA1 + 1 * DM, Hb, RSS + MT};
        pg8::gemm_phase<pg8::EpiResid<true>, pg8::StaticOrder, true, true>(ldsl + RING_OFF, g, S, E);
        { const sk::SkResid<true> Es{X + (size_t)MP * DM, X + (size_t)MP * DM, ADA + 5 * DM, A->in[11] + DM, ADA1 + 1 * DM, Hb, RSS + MT};
          sk::sk_gemm<2, false, false, sk::SkResid<true>>(Ab, MP, MS / 64, (const bf16*)(ws + WS_WDN), 0, DM / 64, DFF, (char*)lds + RING_OFF, Es, F.vcu, F.G); }
        if (BOTH(9)) GRID_BAR();
    }
    if (IN(11)) { PHASE_PTRS;
        pg8::Gemm g{Hb, (const bf16*)(ws + WS_WSIN), MP, SWA_IN, DM}; pg8::StaticOrder S; S.init(MP, SWA_IN, F.G, (int)blockIdx.x);
        pg8::EpiSwaIn E{Qb, Kb, Vb, out, (const float*)(ws + WS_ROPE), RSS + MT, (const float*)(ws + WS_SW1)};
        pg8::gemm_phase<pg8::EpiSwaIn, pg8::StaticOrder, true, true>(ldsl + RING_OFF, g, S, E);
        { const sk::SkSwaIn Es{Qb, Kb, Vb, (bf16*)(ws + WS_KSC), (bf16*)(ws + WS_VSC), out, (const float*)(ws + WS_ROPE), RSS + MT, (const float*)(ws + WS_SW1)};
          sk::sk_gemm<2, false, false, sk::SkSwaIn>(Hb, MP, MS / 64, (const bf16*)(ws + WS_WSIN), 0, SWA_IN / 64, DM, (char*)lds + RING_OFF, Es, F.vcu, F.G); }
        if (BOTH(11)) GRID_BAR();
    }
    if (IN(12)) { PHASE_PTRS;
        const swa::Tensors T{Qb, Kb, Vb, Ob, (const bf16*)(ws + WS_KSC), (const bf16*)(ws + WS_VSC), A->in[17]};
        swa::swa_phase((char*)lds + RING_OFF, T, F.vcu, F.G);
        if (BOTH(12)) GRID_BAR();
    }
    if (IN(13)) { PHASE_PTRS;
        pg8::Gemm g{Ob, (const bf16*)(ws + WS_WSOUT), MP, DM, DM}; pg8::StaticOrder S; S.init(MP, DM, F.G, (int)blockIdx.x);
        pg8::EpiResid<true> E{X, X, ADA1 + 2 * DM, A->in[12] + DM, ADA1 + 4 * DM, Hb, RSS + 2 * MT};
        pg8::gemm_phase<pg8::EpiResid<true>, pg8::StaticOrder, true, true>(ldsl + RING_OFF, g, S, E);
        { const sk::SkResid<true> Es{X + (size_t)MP * DM, X + (size_t)MP * DM, ADA1 + 2 * DM, A->in[12] + DM, ADA1 + 4 * DM, Hb, RSS + 2 * MT};
          sk::sk_gemm<2, false, false, sk::SkResid<true>>(Ob, MP, MS / 64, (const bf16*)(ws + WS_WSOUT), 0, DM / 64, DM, (char*)lds + RING_OFF, Es, F.vcu, F.G); }
        if (BOTH(13)) GRID_BAR();
    }
    if (IN(15)) { PHASE_PTRS;
        pg8::Gemm g{Hb, (const bf16*)(ws + WS_WUP) + (size_t)DM * DFF, MP, DFF, DM}; pg8::StaticOrder S; S.init(MP, DFF, F.G, (int)blockIdx.x);
        pg8::EpiUp E{Ab, RSS + 2 * MT, (const float*)(ws + WS_SW2)};
        pg8::gemm_phase<pg8::EpiUp, pg8::StaticOrder, true, true>(ldsl + RING_OFF, g, S, E);
        { const sk::SkUp Es{Ab, RSS + 2 * MT, (const float*)(ws + WS_SW2)}; sk::sk_gemm<2, false, false, sk::SkUp>(Hb, MP, MS / 64, (const bf16*)(ws + WS_WUP) + (size_t)DM * DFF, 0, DFF / 64, DM, (char*)lds + RING_OFF, Es, F.vcu, F.G); }
        if (BOTH(15)) GRID_BAR();
    }
    if (IN(16)) { PHASE_PTRS;
        pg8::Gemm g{Ab, (const bf16*)(ws + WS_WDN) + (size_t)DM * DFF, MP, DM, DFF}; pg8::StaticOrder S; S.init(MP, DM, F.G, (int)blockIdx.x);
        pg8::EpiResid<false> E{X, X, ADA1 + 5 * DM, nullptr, nullptr, nullptr, nullptr};
        pg8::gemm_phase<pg8::EpiResid<false>, pg8::StaticOrder, true, true>(ldsl + RING_OFF, g, S, E);
        { const sk::SkResid<false> Es{X + (size_t)MP * DM, X + (size_t)MP * DM, ADA1 + 5 * DM, nullptr, nullptr, nullptr, nullptr};
          sk::sk_gemm<2, false, false, sk::SkResid<false>>(Ab, MP, MS / 64, (const bf16*)(ws + WS_WDN) + (size_t)DM * DFF, 0, DM / 64, DFF, (char*)lds + RING_OFF, Es, F.vcu, F.G); }
        if (BOTH(16)) GRID_BAR();
    }
    if (IN(17)) { PHASE_PTRS; final_norm(X, A->in[21], F); }
#undef PHASE_PTRS
#undef MKFRAME
#undef IN
#undef BOTH
#undef GRID_BAR
}

extern "C" void kernel_launch(void* const* d_in, const int* in_sizes, int n_in, void* d_out, int out_size, void* d_ws, size_t ws_size, hipStream_t stream) {
    static int grid = 0;
    if (grid == 0) {
        if (n_in != 22 || (size_t)out_size != O_END || ws_size < WS_END) { fprintf(stderr, "kernel_launch: shape mismatch n_in %d out %d (want %zu) ws %zu (want %zu)\n", n_in, out_size, (size_t)O_END, ws_size, (size_t)WS_END); grid = -1; return; }
        int dev = 0, cus = 0, per_cu = 0;
        if (hipGetDevice(&dev) != hipSuccess || hipDeviceGetAttribute(&cus, hipDeviceAttributeMultiprocessorCount, dev) != hipSuccess) { grid = -1; return; }
        if (hipFuncSetAttribute((const void*)mk_fwd, hipFuncAttributeMaxDynamicSharedMemorySize, LDS_BYTES) != hipSuccess) { fprintf(stderr, "kernel_launch: hipFuncSetAttribute failed\n"); grid = -1; return; }
        if (hipOccupancyMaxActiveBlocksPerMultiprocessor(&per_cu, (const void*)mk_fwd, NWAVES * 64, LDS_BYTES) != hipSuccess || per_cu < 1) { fprintf(stderr, "kernel_launch: occupancy query says %d\n", per_cu); }
        (void)hipGetLastError();
        grid = cus;
    }
    if (grid < 0) return;
    (void)hipMemsetAsync((char*)d_ws + WS_CTL, 0, CTL_ZERO_BYTES, stream);
    Args a{};
    for (int i = 0; i < 22; ++i) a.in[i] = (const float*)d_in[i];
    a.out = (float*)d_out; a.ws = (unsigned char*)d_ws;
    if (ONE_LAUNCH) { a.ph_lo = 0; a.ph_hi = N_PHASES; a.li = 0; hipLaunchKernelGGL(mk_fwd, dim3(grid), dim3(NWAVES * 64), LDS_BYTES, stream, a); }
    else { for (int p = 0; p < N_PHASES; ++p) { a.ph_lo = p; a.ph_hi = p + 1; a.li = p; hipLaunchKernelGGL(mk_fwd, dim3(grid), dim3(NWAVES * 64), LDS_BYTES, stream, a); } }
}
```

```cpp
#include <hip/hip_runtime.h>
#include <cstdio>
#include <cstdint>

constexpr int DM = 2048, NB = 2, SEQ = 16384, MP = NB * SEQ, DECB = 16, DECT = 32, MS = DECB * DECT, MT = MP + MS, PAST = 1024, DFF = 8192;
constexpr int FH = 16, FHD = 128, FOX_IN = 3 * DM + FH, FOX_IN_PAD = 6400;
constexpr int SWH = 32, SKV = 4, SHD = 64, SWA_IN = DM + 2 * SKV * SHD, WBUF = 128;
constexpr int NADA = 18, ADAW = 6 * DM;
constexpr float RMS_EPS = 1e-6f;
constexpr int KCROWS = 1088;
constexpr int SROWS = 160;

constexpr size_t O_Y = 0;
constexpr size_t O_FKP = (size_t)MT * DM;
constexpr size_t O_FVP = O_FKP + (size_t)MP * DM;
constexpr size_t O_FLP = O_FVP + (size_t)MP * DM;
constexpr size_t O_FKS = O_FLP + (size_t)MP * FH;
constexpr size_t O_FVS = O_FKS + (size_t)MS * DM;
constexpr size_t O_FLS = O_FVS + (size_t)MS * DM;
constexpr size_t O_SKP = O_FLS + (size_t)MS * FH;
constexpr size_t O_SVP = O_SKP + (size_t)NB * WBUF * 256;
constexpr size_t O_SKS = O_SVP + (size_t)NB * WBUF * 256;
constexpr size_t O_SVS = O_SKS + (size_t)DECB * WBUF * 256;
constexpr size_t O_END = O_SVS + (size_t)DECB * WBUF * 256;

constexpr size_t MiB = 1u << 20;
constexpr size_t WS_CTL = 0, CTL_ZERO_BYTES = 1 * MiB;
constexpr size_t WS_ADA = 1 * MiB;
constexpr size_t WS_ROPE = 3 * MiB;
constexpr size_t WS_SH = 4 * MiB;
constexpr size_t WS_SW0 = 5 * MiB;
constexpr size_t WS_SW1 = 6 * MiB;
constexpr size_t WS_SW2 = 7 * MiB;
constexpr size_t WS_KSC = 8 * MiB;
constexpr size_t WS_VSC = 10 * MiB;
constexpr size_t WS_WFIN = 12 * MiB;
constexpr size_t WS_WFOUT = 37 * MiB;
constexpr size_t WS_WSIN = 45 * MiB;
constexpr size_t WS_WSOUT = 55 * MiB;
constexpr size_t WS_WUP = 63 * MiB;
constexpr size_t WS_WDN = 127 * MiB;
constexpr size_t WS_H = 191 * MiB;
constexpr size_t WS_Q = 321 * MiB;
constexpr size_t WS_K = 451 * MiB;
constexpr size_t WS_V = 581 * MiB;
constexpr size_t WS_O = 711 * MiB;
constexpr size_t WS_A = WS_Q;
constexpr size_t WS_KC = 841 * MiB;
constexpr size_t WS_VC = 909 * MiB;
constexpr size_t WS_CKP = 977 * MiB;
constexpr size_t WS_CQP = 985 * MiB;
constexpr size_t WS_CKS = 993 * MiB;
constexpr size_t WS_CQS = 998 * MiB;
constexpr size_t WS_QN = 1003 * MiB;
constexpr size_t WS_KN = 1005 * MiB;
constexpr size_t WS_SD = 1007 * MiB;
constexpr size_t WS_JLO = 1009 * MiB;
constexpr size_t WS_LFH = 1010 * MiB;
constexpr size_t WS_END = 1012 * MiB;
static_assert((size_t)MT * DM * 2 == 130 * MiB && (size_t)MT * DFF * 2 == 520 * MiB && (size_t)DECB * KCROWS * DM * 2 == 68 * MiB, "map");

constexpr int CW_TMO = 0, CW_CODE = 1, CW_BAR = 4096, CW_DYN = 12288;
constexpr size_t CTL_RSS = 65536;
static_assert(CTL_RSS + 3 * (size_t)MT * 4 <= CTL_ZERO_BYTES, "rss inside the memset region");

#define GAS __attribute__((address_space(1)))
#define LAS __attribute__((address_space(3)))
typedef unsigned short bf16;
typedef unsigned v4u __attribute__((ext_vector_type(4)));
typedef unsigned v2u __attribute__((ext_vector_type(2)));
typedef float f32x4 __attribute__((ext_vector_type(4)));
typedef float f32x16 __attribute__((ext_vector_type(16)));
typedef short bf16x8 __attribute__((ext_vector_type(8)));
typedef short s16x4 __attribute__((ext_vector_type(4)));
typedef GAS unsigned gu32;
#define RLX_AGENT __ATOMIC_RELAXED, __HIP_MEMORY_SCOPE_AGENT
#define LDS_WAIT() asm volatile("s_waitcnt lgkmcnt(0)" ::: "memory")
#define VM_WAIT() asm volatile("s_waitcnt vmcnt(0)" ::: "memory")
__device__ __forceinline__ unsigned cvtpk(float lo, float hi) { unsigned r; asm volatile("v_cvt_pk_bf16_f32 %0, %1, %2" : "=v"(r) : "v"(lo), "v"(hi)); return r; }
__device__ __forceinline__ int arow_of(int row) { return row < MP ? (row >> 14) : 2 + ((row - MP) >> 5); }

__device__ __forceinline__ int fresh_tid() { int t = threadIdx.x; asm volatile("" : "+v"(t)); return t; }
__device__ __forceinline__ size_t tiled_off(int row, int k, int K) {
    const int r = row & 127, c = k & 63, st = (r >> 4) * 2 + (c >> 5), ob = (r & 15) * 64 + (c & 31) * 2;
    return ((size_t)(row >> 7) * (K >> 6) + (k >> 6)) * 16384 + st * 1024 + (ob ^ (((ob >> 9) & 1) << 5));
}
namespace pg8 {
#define PG8_LAS __attribute__((address_space(3)))
typedef unsigned short bf16_t;
typedef short bf16x8 __attribute__((ext_vector_type(8)));
typedef float f32x4 __attribute__((ext_vector_type(4)));
typedef unsigned u32x4 __attribute__((ext_vector_type(4)));
constexpr int BM = 256, BK = 64, HALF = 128, HTB = HALF * BK * 2  , STAGE_BYTES = 8 * HTB, NXCD = 8, WGM = 4;

__host__ __device__ __forceinline__ int lds_byte(int r, int c) { const int st = (r >> 4) * 2 + (c >> 5), rr = r & 15, cc = c & 31, ob = rr * 64 + cc * 2; return st * 1024 + (ob ^ (((ob >> 9) & 1) << 5)); }
__host__ __device__ __forceinline__ void stage_rc(int b, int& R, int& C) { const int st = b / 1024, sb = b % 1024, swz = sb ^ (((sb >> 9) & 1) << 5); R = (st >> 1) * 16 + swz / 64; C = (st & 1) * 32 + (swz % 64) / 2; }
__host__ __device__ __forceinline__ int perm32(int rho) { const int n = rho >> 4, i = rho & 15; return 8 * (i >> 2) + 4 * n + (i & 3); }

struct Unit { int pm, pn; };
struct Gemm { const bf16_t* A; const bf16_t* Bt; int M, N, K; };

struct StaticOrder {
    int nM, nN, nwg, G, c;
    __host__ __device__ void init(int M, int N, int G_, int c_) { nM = M / BM; nN = N / BM; nwg = nM * nN; G = G_; c = c_; }
    __host__ __device__ bool next(int i, Unit& u) const {
        const long L = (long)i * G + c; if (L >= nwg) return false;
        int wgid = (int)L; { const int q = nwg / NXCD, r = nwg % NXCD, xcd = wgid % NXCD, off = wgid / NXCD; wgid = (xcd < r ? xcd * (q + 1) : r * (q + 1) + (xcd - r) * q) + off; }
        const int nig = WGM * nN, gid = wgid / nig, fm = gid * WGM, gsz = (nM - fm) < WGM ? (nM - fm) : WGM;
        u.pm = fm + ((wgid % nig) % gsz); u.pn = (wgid % nig) / gsz; return true;
    }
    __device__ __forceinline__ void a_ready(const Unit&) const {}
    __device__ __forceinline__ int fetch(bool) const { return 0; }
    __device__ __forceinline__ void publish(int, bool, int) const {}
    __device__ __forceinline__ void done(const Unit&) const {}
};

struct DynOrder {
    int nM, nN, q, c, slot; unsigned* ctr;
    __device__ __forceinline__ int pack_tile(int wgid) const { const int nig = WGM * nN, gid = wgid / nig, fm = gid * WGM, gsz = (nM - fm) < WGM ? (nM - fm) : WGM;
        return ((fm + ((wgid % nig) % gsz)) << 8) | ((wgid % nig) / gsz); }
    __device__ __forceinline__ int draw() const { int got = -1;
        for (int k = 0; k < NXCD; ++k) { const int y = (c + k) & 7; const int n = (int)__hip_atomic_fetch_add(ctr + 64 * y, 1u, __ATOMIC_RELAXED, __HIP_MEMORY_SCOPE_AGENT); if (n < q) { got = pack_tile(y * q + n); break; } }
        return got; }
    __device__ __forceinline__ void init(int M, int N, int c_, unsigned* ctr_, int slot_) { nM = M / BM; nN = N / BM; q = nM * nN / NXCD; c = c_; ctr = ctr_; slot = slot_;
        if (threadIdx.x == 0) { const int u0 = draw(); const int u1 = u0 >= 0 ? draw() : -1; *(volatile PG8_LAS int*)(slot) = u0; *(volatile PG8_LAS int*)(slot + 4) = u1; }
        __syncthreads(); }
    __device__ __forceinline__ bool next(int i, Unit& u) const {
        const int v = __builtin_amdgcn_readfirstlane(*(volatile PG8_LAS int*)(slot + 4 * (i & 1))); if (v < 0) return false;
        u.pm = v >> 8; u.pn = v & 255; return true;
    }
    __device__ __forceinline__ void a_ready(const Unit&) const {}
    __device__ __forceinline__ int fetch(bool has_next) const { int got = -1; if (has_next && threadIdx.x == 0) got = draw(); return got; }
    __device__ __forceinline__ void publish(int i, bool has_next, int got) const { if (has_next && threadIdx.x == 0) *(volatile PG8_LAS int*)(slot + 4 * (i & 1)) = got; }
    __device__ __forceinline__ void done(const Unit&) const {}
};
__device__ __forceinline__ unsigned cvt_pk_bf16(float lo, float hi) { unsigned r; asm volatile("v_cvt_pk_bf16_f32 %0, %1, %2" : "=v"(r) : "v"(lo), "v"(hi)); return r; }

typedef unsigned u32x2 __attribute__((ext_vector_type(2)));
__device__ __forceinline__ u32x2 pack4(f32x4 v) { u32x2 w; w.x = cvt_pk_bf16(v[0], v[1]); w.y = cvt_pk_bf16(v[2], v[3]); return w; }

__device__ __forceinline__ u32x4 pack8(f32x4 a, f32x4 b) { u32x4 w; w.x = cvt_pk_bf16(a[0], a[1]); w.y = cvt_pk_bf16(a[2], a[3]); w.z = cvt_pk_bf16(b[0], b[1]); w.w = cvt_pk_bf16(b[2], b[3]); return w; }
struct EpiFoxIn {
    static constexpr bool PERM = true, AFTER_DRAIN = false;
    bf16_t* Q; size_t qkv_stride; float* out;
    __device__ __forceinline__ void operator()(const f32x4 (&acc)[2][2][4][2], const Unit& u, int wr, int wc, int fr, int fq) const {
        const int kind = u.pn >> 3, colt = (u.pn & 7) * 256;
        bf16_t* T = Q + (size_t)kind * qkv_stride; float* o = out + O_FKP + (size_t)(kind - 1) * ((size_t)MP * DM);
#pragma unroll
        for (int ai = 0; ai < 2; ++ai)
#pragma unroll
            for (int m = 0; m < 4; ++m) {
                const int row = u.pm * BM + ai * HALF + wr * 64 + m * 16 + fr;
#pragma unroll
                for (int bj = 0; bj < 2; ++bj) {
                    const int col = colt + bj * HALF + wc * 32 + fq * 8; const f32x4 v0 = acc[ai][bj][m][0], v1 = acc[ai][bj][m][1];
                    *(u32x4*)(T + (size_t)row * DM + col) = pack8(v0, v1);
                    if (kind != 0) { float* op = o + (size_t)row * DM + col; *(f32x4*)op = v0; *(f32x4*)(op + 4) = v1; }
                }
            }
    }
};
template <bool FUSE> struct EpiResid {
    static constexpr bool PERM = true, AFTER_DRAIN = false;
    const float* base; float* X; const float* gate;
    const float* ng; const float* nsc; bf16_t* H; float* rss;
    __device__ __forceinline__ void operator()(const f32x4 (&acc)[2][2][4][2], const Unit& u, int wr, int wc, int fr, int fq) const {
        const int b = u.pm >> 6; const float* gp = gate + (size_t)b * ADAW; const float* sp = nsc + (size_t)b * ADAW;
        f32x4 gv[2][2], cs[2][2];
#pragma unroll
        for (int bj = 0; bj < 2; ++bj)
#pragma unroll
            for (int n = 0; n < 2; ++n) { const int col = u.pn * BM + bj * HALF + wc * 32 + fq * 8 + n * 4; gv[bj][n] = *(const f32x4*)(gp + col);
                if (FUSE) cs[bj][n] = *(const f32x4*)(ng + col) * (*(const f32x4*)(sp + col) + 1.0f); }
#pragma unroll
        for (int ai = 0; ai < 2; ++ai)
#pragma unroll
            for (int m = 0; m < 4; ++m) {
                const int row = u.pm * BM + ai * HALF + wr * 64 + m * 16 + fr;
                const float* bp = base + (size_t)row * DM; float* xp = X + (size_t)row * DM; float ss = 0.f;
#pragma unroll
                for (int bj = 0; bj < 2; ++bj) {
                    const int col = u.pn * BM + bj * HALF + wc * 32 + fq * 8;
                    const f32x4 x0 = *(const f32x4*)(bp + col) + gv[bj][0] * acc[ai][bj][m][0], x1 = *(const f32x4*)(bp + col + 4) + gv[bj][1] * acc[ai][bj][m][1];
                    *(f32x4*)(xp + col) = x0; *(f32x4*)(xp + col + 4) = x1;
                    if (FUSE) { ss += ((x0[0] * x0[0] + x0[1] * x0[1]) + (x0[2] * x0[2] + x0[3] * x0[3])) + ((x1[0] * x1[0] + x1[1] * x1[1]) + (x1[2] * x1[2] + x1[3] * x1[3]));
                        *(u32x4*)((char*)H + tiled_off(row, col, DM)) = pack8(x0 * cs[bj][0], x1 * cs[bj][1]); }
                }
                if (FUSE) { ss += __shfl_xor(ss, 16); ss += __shfl_xor(ss, 32);
                    if (fq == 0) (void)__hip_atomic_fetch_add(rss + row, ss, __ATOMIC_RELAXED, __HIP_MEMORY_SCOPE_AGENT); }
            }
    }
};
struct EpiUp {
    static constexpr bool PERM = true, AFTER_DRAIN = false;
    bf16_t* A; const float* rss; const float* sw;
    __device__ __forceinline__ void operator()(const f32x4 (&acc)[2][2][4][2], const Unit& u, int wr, int wc, int fr, int fq) const {
        const float* swp = sw + (size_t)(u.pm >> 6) * DFF; f32x4 sv[2][2];
#pragma unroll
        for (int bj = 0; bj < 2; ++bj)
#pragma unroll
            for (int n = 0; n < 2; ++n) sv[bj][n] = *(const f32x4*)(swp + u.pn * BM + bj * HALF + wc * 32 + fq * 8 + n * 4);
#pragma unroll
        for (int ai = 0; ai < 2; ++ai)
#pragma unroll
            for (int m = 0; m < 4; ++m) {
                const int row = u.pm * BM + ai * HALF + wr * 64 + m * 16 + fr; bf16_t* ap = A + (size_t)row * DFF;
                const float rstd = 1.0f / sqrtf(rss[row] * (1.0f / DM) + RMS_EPS);
#pragma unroll
                for (int bj = 0; bj < 2; ++bj) {
                    const int col = u.pn * BM + bj * HALF + wc * 32 + fq * 8; f32x4 v0 = acc[ai][bj][m][0] * rstd + sv[bj][0], v1 = acc[ai][bj][m][1] * rstd + sv[bj][1];
#pragma unroll
                    for (int e = 0; e < 4; ++e) { const float r0 = fmaxf(v0[e], 0.f), r1 = fmaxf(v1[e], 0.f); v0[e] = r0 * r0; v1[e] = r1 * r1; }
                    u32x4 w; w.x = cvt_pk_bf16(v0[0], v0[1]); w.y = cvt_pk_bf16(v0[2], v0[3]); w.z = cvt_pk_bf16(v1[0], v1[1]); w.w = cvt_pk_bf16(v1[2], v1[3]);
                    *(u32x4*)(ap + col) = w;
                }
            }
    }
};
struct EpiSwaIn {
    static constexpr bool PERM = true, AFTER_DRAIN = false;
    bf16_t *Q, *K, *V; float* out; const float* rope; const float* rss; const float* sw;
    __device__ __forceinline__ void operator()(const f32x4 (&acc)[2][2][4][2], const Unit& u, int wr, int wc, int fr, int fq) const {
        const int kind = u.pn < 8 ? 0 : (u.pn == 8 ? 1 : 2); const float* swp = sw + (size_t)(u.pm >> 6) * SWA_IN + u.pn * BM;
#pragma unroll
        for (int ai = 0; ai < 2; ++ai)
#pragma unroll
            for (int m = 0; m < 4; ++m) {
                const int row = u.pm * BM + ai * HALF + wr * 64 + m * 16 + fr, t = row & (SEQ - 1);
                const float rstd = 1.0f / sqrtf(rss[row] * (1.0f / DM) + RMS_EPS);
#pragma unroll
                for (int bj = 0; bj < 2; ++bj) {
                    const int c = bj * HALF + wc * 32 + fq * 8;
                    f32x4 v0 = acc[ai][bj][m][0] * rstd + *(const f32x4*)(swp + c), v1 = acc[ai][bj][m][1] * rstd + *(const f32x4*)(swp + c + 4);
                    if (kind != 2 && (wc & 1) == 0) {
                        f32x4 p0, p1;
#pragma unroll
                        for (int e = 0; e < 4; ++e) { p0[e] = __shfl_xor(v0[e], 16); p1[e] = __shfl_xor(v1[e], 16); }
                        const float* rp = rope + (size_t)t * 16;
                        const f32x4 c0 = *(const f32x4*)rp, c1 = *(const f32x4*)(rp + 4), s0 = *(const f32x4*)(rp + 8), s1 = *(const f32x4*)(rp + 12);
                        if (fq == 0) { v0 = v0 * c0 - p0 * s0; v1 = v1 * c1 - p1 * s1; } else if (fq == 1) { v0 = v0 * c0 + p0 * s0; v1 = v1 * c1 + p1 * s1; }
                    }
                    const u32x4 w = pack8(v0, v1);
                    if (kind == 0) { *(u32x4*)(Q + (size_t)row * DM + u.pn * BM + c) = w; }
                    else { bf16_t* T = kind == 1 ? K : V; *(u32x4*)(T + (size_t)row * 256 + c) = w;
                        if (t >= SEQ - WBUF) { float* op = out + (kind == 1 ? O_SKP : O_SVP) + ((size_t)(row >> 14) * WBUF + (t - (SEQ - WBUF))) * 256 + c; *(f32x4*)op = v0; *(f32x4*)(op + 4) = v1; } }
                }
            }
    }
};
template <class Epi, class Sched, bool ALIGN_EPI = false, bool SP2 = false, bool ATILED = false, bool BTILED = false>
__device__ __forceinline__ void gemm_phase(PG8_LAS unsigned char* lds, const Gemm g, const Sched& S, const Epi& E) {
    const int tid = fresh_tid(), wid = __builtin_amdgcn_readfirstlane(tid >> 6), lane = tid & 63, wr = wid >> 2, wc = wid & 3, fr = lane & 15, fq = lane >> 4;
    const int K = g.K, nt = K / BK;
    unsigned voffA[2], voffB[2];
#pragma unroll
    for (int i = 0; i < 2; ++i) { int R, C; stage_rc(tid * 16 + i * 8192, R, C); const int Rb = Epi::PERM ? ((R & ~31) + perm32(R & 31)) : R;
        voffA[i] = ATILED ? (unsigned)(tid * 16 + i * 8192) : (unsigned)(R * K + C) * 2u; voffB[i] = BTILED ? (unsigned)(tid * 16 + i * 8192) : (unsigned)(Rb * K + C) * 2u; }
    const size_t kstepA = ATILED ? (size_t)HTB : (size_t)(BK * 2), kstepB = BTILED ? (size_t)HTB : (size_t)(BK * 2);
    const size_t hstep = (size_t)HALF * K * 2;
    const size_t tstep = 2 * hstep;
    const unsigned ldsw = (unsigned)wid * 1024u;
    const int aoff = lds_byte(wr * 64 + fr, fq * 8), boff = lds_byte(wc * 32 + fr, fq * 8);
#define PG8_SA(b, h) (((b) * 2 + (h)) * HTB)
#define PG8_SB(b, h) ((4 + (b) * 2 + (h)) * HTB)
#define PG8_STAGE(bufoff, gbase, voff) do { _Pragma("unroll") for (int _i = 0; _i < 2; ++_i) { unsigned keep_; \
        asm volatile("s_mov_b32 %0, m0\n\ts_mov_b32 m0, %3\n\ts_nop 0\n\tglobal_load_lds_dwordx4 %1, %2\n\ts_mov_b32 m0, %0" \
                     : "=&s"(keep_) : "v"((voff)[_i]), "s"((const char*)(gbase)), "s"((unsigned)(uintptr_t)(lds + (bufoff) + ldsw + _i * 8192)) : "memory"); } } while (0)
#define PG8_LDA(dst, b, h) do { _Pragma("unroll") for (int m = 0; m < 4; ++m) _Pragma("unroll") for (int k = 0; k < 2; ++k) dst[m][k] = *(const PG8_LAS bf16x8*)(lds + PG8_SA(b, h) + aoff + m * 2048 + k * 1024); } while (0)
#define PG8_LDB(dst, b, h) do { _Pragma("unroll") for (int n = 0; n < 2; ++n) _Pragma("unroll") for (int k = 0; k < 2; ++k) dst[n][k] = *(const PG8_LAS bf16x8*)(lds + PG8_SB(b, h) + boff + n * 2048 + k * 1024); } while (0)
#define PG8_MMA(ai, bj, At, Bt) do { __builtin_amdgcn_s_setprio(1); _Pragma("unroll") for (int m = 0; m < 4; ++m) _Pragma("unroll") for (int n = 0; n < 2; ++n) _Pragma("unroll") for (int k = 0; k < 2; ++k) \
        acc[ai][bj][m][n] = __builtin_amdgcn_mfma_f32_16x16x32_bf16(Bt[n][k], At[m][k], acc[ai][bj][m][n], 0, 0, 0); __builtin_amdgcn_s_setprio(0); } while (0)
#define PG8_WAIT_V(n) asm volatile("s_waitcnt vmcnt(" #n ")" ::: "memory")
#define PG8_WAIT_L(n) asm volatile("s_waitcnt lgkmcnt(" #n ")" ::: "memory")
#define PG8_BAR __builtin_amdgcn_s_barrier()
#define PG8_SCHED __builtin_amdgcn_sched_barrier(0)
    Unit cur, nxt; int ui = 0;
    if (!S.next(0, cur)) return;
    f32x4 acc[2][2][4][2];
#pragma unroll
    for (int a = 0; a < 2; ++a)
#pragma unroll
        for (int b = 0; b < 2; ++b)
#pragma unroll
            for (int m = 0; m < 4; ++m)
#pragma unroll
                for (int n = 0; n < 2; ++n) acc[a][b][m][n] = (f32x4){0.f, 0.f, 0.f, 0.f};
    bf16x8 At[4][2], B0[2][2], B1[2][2];
    const char* cA = (const char*)g.A + (size_t)cur.pm * tstep; const char* cB = (const char*)g.Bt + (size_t)cur.pn * tstep;
    S.a_ready(cur);
    if constexpr (SP2) {
        PG8_STAGE(PG8_SB(0, 0), cB, voffB); PG8_STAGE(PG8_SB(0, 1), cB + hstep, voffB); PG8_STAGE(PG8_SA(0, 0), cA, voffA); PG8_STAGE(PG8_SA(0, 1), cA + hstep, voffA);
        if (wr == 1) PG8_BAR;
        PG8_WAIT_V(2); PG8_BAR;
        PG8_STAGE(PG8_SB(1, 0), cB + kstepB, voffB); PG8_STAGE(PG8_SA(1, 0), cA + kstepA, voffA); PG8_STAGE(PG8_SB(1, 1), cB + hstep + kstepB, voffB);
        PG8_WAIT_V(6); PG8_BAR;
    } else {
        PG8_STAGE(PG8_SB(0, 0), cB, voffB); PG8_STAGE(PG8_SA(0, 0), cA, voffA); PG8_STAGE(PG8_SB(0, 1), cB + hstep, voffB); PG8_STAGE(PG8_SA(0, 1), cA + hstep, voffA);
        if (wr == 1) PG8_BAR;
        PG8_WAIT_V(4); PG8_BAR;
        PG8_STAGE(PG8_SB(1, 0), cB + kstepB, voffB); PG8_STAGE(PG8_SA(1, 0), cA + kstepA, voffA); PG8_STAGE(PG8_SB(1, 1), cB + hstep + kstepB, voffB);
        PG8_WAIT_V(6); PG8_BAR;
    }
    for (;;) {
        bool has_next = false; int fetched = -1;
        const char* nA = cA; const char* nB = cB;
        for (int t = 0; t < nt; t += 2) {
            const bool last = (t == nt - 2);
            if (last) { has_next = S.next(ui + 1, nxt); if (has_next) { nA = (const char*)g.A + (size_t)nxt.pm * tstep; nB = (const char*)g.Bt + (size_t)nxt.pn * tstep; } }
            const char* a1 = cA + (size_t)(t + 1) * kstepA;
            const char* a2 = last ? nA : cA + (size_t)(t + 2) * kstepA; const char* b2 = last ? nB : cB + (size_t)(t + 2) * kstepB;
            const char* a3 = a2 + kstepA; const char* b3 = b2 + kstepB;
            if (last && has_next) S.a_ready(nxt);
            if constexpr (SP2) {
            PG8_LDB(B0, 0, 0); PG8_LDB(B1, 0, 1); PG8_SCHED; PG8_LDA(At, 0, 0); PG8_STAGE(PG8_SA(1, 1), a1 + hstep, voffA);
            PG8_WAIT_V(8); PG8_WAIT_L(0); PG8_BAR; PG8_MMA(0, 0, At, B0); PG8_MMA(0, 1, At, B1); PG8_BAR; PG8_SCHED;
            PG8_LDA(At, 0, 1); PG8_STAGE(PG8_SB(0, 0), b2, voffB); PG8_STAGE(PG8_SB(0, 1), b2 + hstep, voffB); PG8_STAGE(PG8_SA(0, 0), a2, voffA);
            PG8_WAIT_V(8); PG8_WAIT_L(0); PG8_BAR; PG8_MMA(1, 0, At, B0); PG8_MMA(1, 1, At, B1); PG8_BAR; PG8_SCHED;
            PG8_LDB(B0, 1, 0); PG8_LDB(B1, 1, 1); PG8_SCHED; PG8_LDA(At, 1, 0); PG8_STAGE(PG8_SA(0, 1), a2 + hstep, voffA);
            PG8_WAIT_V(8); PG8_WAIT_L(0); PG8_BAR; PG8_MMA(0, 0, At, B0); PG8_MMA(0, 1, At, B1); PG8_BAR; PG8_SCHED;
            PG8_LDA(At, 1, 1); PG8_STAGE(PG8_SB(1, 0), b3, voffB); PG8_STAGE(PG8_SB(1, 1), b3 + hstep, voffB); PG8_STAGE(PG8_SA(1, 0), a3, voffA);
            PG8_WAIT_V(8); PG8_WAIT_L(0); PG8_BAR; PG8_MMA(1, 0, At, B0); PG8_MMA(1, 1, At, B1); PG8_BAR; PG8_SCHED;
            } else {
            PG8_LDB(B0, 0, 0); PG8_SCHED; PG8_LDA(At, 0, 0); PG8_STAGE(PG8_SA(1, 1), a1 + hstep, voffA);
            PG8_WAIT_L(8); PG8_BAR; PG8_WAIT_L(0); PG8_MMA(0, 0, At, B0); PG8_BAR; PG8_SCHED;
            PG8_LDB(B1, 0, 1); PG8_STAGE(PG8_SB(0, 0), b2, voffB);
            PG8_BAR; PG8_WAIT_L(0); PG8_MMA(0, 1, At, B1); PG8_BAR;
            PG8_LDA(At, 0, 1); PG8_STAGE(PG8_SA(0, 0), a2, voffA);
            PG8_BAR; PG8_WAIT_L(0); PG8_MMA(1, 0, At, B0); PG8_BAR; PG8_SCHED;
            PG8_STAGE(PG8_SB(0, 1), b2 + hstep, voffB);
            PG8_WAIT_V(6); PG8_BAR; PG8_MMA(1, 1, At, B1); PG8_BAR;
            PG8_LDB(B0, 1, 0); PG8_SCHED; PG8_LDA(At, 1, 0); PG8_STAGE(PG8_SA(0, 1), a2 + hstep, voffA);
            PG8_WAIT_L(8); PG8_BAR; PG8_WAIT_L(0); PG8_MMA(0, 0, At, B0); PG8_BAR; PG8_SCHED;
            PG8_LDB(B1, 1, 1); PG8_STAGE(PG8_SB(1, 0), b3, voffB);
            PG8_BAR; PG8_WAIT_L(0); PG8_MMA(0, 1, At, B1); PG8_BAR;
            PG8_LDA(At, 1, 1); PG8_STAGE(PG8_SA(1, 0), a3, voffA);
            PG8_BAR; PG8_WAIT_L(0); PG8_MMA(1, 0, At, B0); PG8_BAR; PG8_SCHED;
            PG8_STAGE(PG8_SB(1, 1), b3 + hstep, voffB);
            PG8_WAIT_V(6); PG8_BAR; PG8_MMA(1, 1, At, B1); PG8_BAR;
            }
        }
        if constexpr (ALIGN_EPI) { if (wr == 0) PG8_BAR; }
        if constexpr (!Epi::AFTER_DRAIN) { fetched = S.fetch(has_next); E(acc, cur, wr, wc, fr, fq); S.publish(ui, has_next, fetched); S.done(cur); }
        if (!has_next) break;
#pragma unroll
        for (int a = 0; a < 2; ++a)
#pragma unroll
            for (int b = 0; b < 2; ++b)
#pragma unroll
                for (int m = 0; m < 4; ++m)
#pragma unroll
                    for (int n = 0; n < 2; ++n) acc[a][b][m][n] = (f32x4){0.f, 0.f, 0.f, 0.f};
        cur = nxt; cA = nA; cB = nB; ++ui;
        if constexpr (ALIGN_EPI) { if (wr == 1) PG8_BAR; }
    }
    PG8_WAIT_V(0);
    if constexpr (!ALIGN_EPI) { if (wr == 0) PG8_BAR; }
    PG8_BAR;
    if constexpr (Epi::AFTER_DRAIN) { E.fused(acc, cur, wr, wc, fr, fq, lds, wid, lane); S.done(cur); }
#undef PG8_SA
#undef PG8_SB
#undef PG8_STAGE
#undef PG8_LDA
#undef PG8_LDB
#undef PG8_MMA
#undef PG8_WAIT_V
#undef PG8_WAIT_L
#undef PG8_BAR
#undef PG8_SCHED
}
}

namespace fox {
constexpr int D = 128, PITCH = 2048;
constexpr float SCALE = 0.08838834764831845f;
constexpr float THR = 8.f;
constexpr int NW = 8, QBLK = 32, KVBLK = 64, QB = NW * QBLK;
constexpr int SHM_V = KVBLK * D * 2, SHM_K = KVBLK * D * 2;
constexpr int OFF_WS = 2 * SHM_V + 2 * SHM_K, OFF_C = OFF_WS + NW * 64 * 4, LDS_BYTES = OFF_C + 3104;
#define KSWZ(row, colB) ((row) * 256 + ((colB) ^ (((row) & 7) << 4)))
#define SBAR() __builtin_amdgcn_sched_barrier(0)
__device__ __forceinline__ int v_st(int k, int c) { const int kk = (k & ~0xC) | ((k & 4) << 1) | ((k & 8) >> 1); return ((kk >> 3) * 4 + (c >> 5)) * 512 + ((kk & 7) * 32 + (c & 31)) * 2; }
__device__ __forceinline__ int v_rd_base(int lane) { return ((lane & 3) << 3) | (((lane >> 2) & 3) << 6) | (((lane >> 4) & 1) << 5) | (((lane >> 5) & 1) << 8); }
constexpr int v_rd_off(int d0, int ks, int half) { return d0 * 512 + ks * 4096 + half * 2048; }
__device__ __forceinline__ int crow(int r, int hi) { return (r & 3) + 8 * (r >> 2) + 4 * hi; }
__device__ __forceinline__ bf16x8 load8(const bf16* p) { return *reinterpret_cast<const bf16x8*>(p); }
__device__ __forceinline__ void mask_tile(f32x16& p0, f32x16& p1, int dq) {
    const float NEG = -__builtin_inff();
#pragma unroll
    for (int r = 0; r < 16; ++r) {
        const int c = (r & 3) + 8 * (r >> 2);
        if (dq - c < 0) p0[r] = NEG;
        if (dq - c - 32 < 0) p1[r] = NEG;
    }
}
__device__ __forceinline__ void partialSM(f32x16& p0, f32x16& p1, float& m_reg, float& mn, float& alpha) {
    float pmax = p0[0]; for (int r = 1; r < 16; ++r) pmax = fmaxf(pmax, p0[r]); for (int r = 0; r < 16; ++r) pmax = fmaxf(pmax, p1[r]);
    { auto rr = __builtin_amdgcn_permlane32_swap(__float_as_uint(pmax), __float_as_uint(pmax), false, false);
      pmax = fmaxf(__uint_as_float(rr[0]), __uint_as_float(rr[1])); }
    constexpr float C2 = 1.4426950408889634f * SCALE;
    if (__builtin_expect(__all((pmax - m_reg) * SCALE <= THR), 1)) { mn = m_reg; alpha = 1.f; }
    else { mn = fmaxf(m_reg, pmax); alpha = __builtin_amdgcn_exp2f((m_reg - mn) * C2); m_reg = mn; }
    const float mnL = -mn * C2;
    for (int r = 0; r < 16; ++r) p0[r] = fmaf(p0[r], C2, mnL); for (int r = 0; r < 16; ++r) p1[r] = fmaf(p1[r], C2, mnL);
    for (int r = 0; r < 16; ++r) p0[r] = __builtin_amdgcn_exp2f(p0[r]);
}
__device__ __forceinline__ void finishSM(f32x16& p0, f32x16& p1, float alpha, float& l_reg, bf16x8& pa0, bf16x8& pa1, bf16x8& pa2, bf16x8& pa3) {
    for (int r = 0; r < 16; ++r) p1[r] = __builtin_amdgcn_exp2f(p1[r]);
    float ps = 0; for (int r = 0; r < 16; ++r) ps += p0[r]; for (int r = 0; r < 16; ++r) ps += p1[r];
    { auto rr = __builtin_amdgcn_permlane32_swap(__float_as_uint(ps), __float_as_uint(ps), false, false);
      ps = __uint_as_float(rr[0]) + __uint_as_float(rr[1]); }
    l_reg = l_reg * alpha + ps;
#define PK4(P, B_, OUT) do { unsigned a0 = cvtpk(P[B_+0], P[B_+1]), a1 = cvtpk(P[B_+2], P[B_+3]);                          \
        unsigned b0 = cvtpk(P[B_+4], P[B_+5]), b1 = cvtpk(P[B_+6], P[B_+7]);                                             \
        auto r0 = __builtin_amdgcn_permlane32_swap(a0, b0, false, false); auto r1 = __builtin_amdgcn_permlane32_swap(a1, b1, false, false); \
        v4u w = {r0[0], r1[0], r0[1], r1[1]}; OUT = *reinterpret_cast<bf16x8*>(&w); } while (0)
    PK4(p0, 0, pa0); PK4(p0, 8, pa1); PK4(p1, 0, pa2); PK4(p1, 8, pa3);
}
template <int KB>
__device__ __forceinline__ void qkt(f32x16& p0, f32x16& p1, const char* K_lds, const char* C_lds, int r32, int hi, const bf16x8* qr, bf16x8 cqf, int caddr) {
    const bf16x8 ca = *reinterpret_cast<const bf16x8*>(C_lds + KB * 1024 + caddr);
    const bf16x8 cb = *reinterpret_cast<const bf16x8*>(C_lds + KB * 1024 + caddr + (hi ? 0 : 512));
    p0 = __builtin_amdgcn_mfma_f32_32x32x16_bf16(ca, cqf, f32x16{}, 0, 0, 0);
    p1 = __builtin_amdgcn_mfma_f32_32x32x16_bf16(cb, cqf, f32x16{}, 0, 0, 0);
    const char* kb[4];
#pragma unroll
    for (int dd = 0; dd < 4; ++dd) kb[dd] = K_lds + KB * SHM_K + KSWZ(r32, (dd * 16 + hi * 8) * 2);
#pragma unroll
    for (int d0 = 0; d0 < 8; ++d0) { const char* a = kb[d0 & 3] + (d0 >> 2) * 128;
        bf16x8 b0 = *reinterpret_cast<const bf16x8*>(a);
        bf16x8 b1 = *reinterpret_cast<const bf16x8*>(a + 32 * 256);
        p0 = __builtin_amdgcn_mfma_f32_32x32x16_bf16(b0, qr[d0], p0, 0, 0, 0);
        p1 = __builtin_amdgcn_mfma_f32_32x32x16_bf16(b1, qr[d0], p1, 0, 0, 0); }
}
template <int VB>
__device__ __forceinline__ void pv_tile(f32x16* o, int vb0, bf16x8 pa0, bf16x8 pa1, bf16x8 pa2, bf16x8 pa3) {
#define TRRD(dst, off) asm volatile("ds_read_b64_tr_b16 %0, %1 offset:%2" : "=&v"(dst) : "v"(vb0), "i"(off) : "memory")
#define PV_D0(d0) do { s16x4 l0, l1, l2, l3, h0, h1, h2, h3; constexpr int b_ = VB * SHM_V + v_rd_off(d0, 0, 0); \
        TRRD(l0, b_); TRRD(h0, b_ + 2048); TRRD(l1, b_ + 4096); TRRD(h1, b_ + 6144); TRRD(l2, b_ + 8192); TRRD(h2, b_ + 10240); TRRD(l3, b_ + 12288); TRRD(h3, b_ + 14336); \
        asm volatile("s_waitcnt lgkmcnt(0)" ::: "memory"); SBAR();   \
        o[d0] = __builtin_amdgcn_mfma_f32_32x32x16_bf16(pa0, (bf16x8){l0[0], l0[1], l0[2], l0[3], h0[0], h0[1], h0[2], h0[3]}, o[d0], 0, 0, 0);   \
        o[d0] = __builtin_amdgcn_mfma_f32_32x32x16_bf16(pa1, (bf16x8){l1[0], l1[1], l1[2], l1[3], h1[0], h1[1], h1[2], h1[3]}, o[d0], 0, 0, 0);   \
        o[d0] = __builtin_amdgcn_mfma_f32_32x32x16_bf16(pa2, (bf16x8){l2[0], l2[1], l2[2], l2[3], h2[0], h2[1], h2[2], h2[3]}, o[d0], 0, 0, 0);   \
        o[d0] = __builtin_amdgcn_mfma_f32_32x32x16_bf16(pa3, (bf16x8){l3[0], l3[1], l3[2], l3[3], h3[0], h3[1], h3[2], h3[3]}, o[d0], 0, 0, 0); } while (0)
    PV_D0(0); PV_D0(1); PV_D0(2); PV_D0(3);
#undef PV_D0
#undef TRRD
}
struct BlockRef { unsigned q0, k0, c0; int P0, wstride, jlo, jhi, samp; };
struct Tensors { const bf16* Q; const bf16* K; const bf16* V; bf16* O; const bf16* KC; const bf16* VC; const bf16* CKP; const bf16* CQP; const bf16* CKS; const bf16* CQS; const int* JLO; };
#define BR_Q(r) (T.Q + (r).q0)
#define BR_O(r) (T.O + (r).q0)
#define BR_K(r) (((r).samp ? T.KC : T.K) + (r).k0)
#define BR_V(r) (((r).samp ? T.VC : T.V) + (r).k0)
#define BR_CK(r) (((r).samp ? T.CKS : T.CKP) + (r).c0)
#define BR_CQ(r) (((r).samp ? T.CQS : T.CQP) + (r).c0)
struct Seam { bf16x8 qr[8]; bf16x8 st_v0, st_v1, st_k0, st_k1; bf16x8 cqf; };
#define VMW() asm volatile("s_waitcnt vmcnt(0)" ::: "memory")
#define VMWN(n) asm volatile("s_waitcnt vmcnt(%0)" :: "i"(n) : "memory")
#define SLOAD_H(Kp, Vp, Cp, k0) do { const bf16* vb_ = (Vp) + (size_t)(k0) * PITCH; const bf16* kb_ = (Kp) + (size_t)(k0) * PITCH;              \
                         S.st_v0 = load8(vb_ + loff); S.st_v1 = load8(vb_ + 32 * PITCH + loff);              \
                         S.st_k0 = load8(kb_ + loff); S.st_k1 = load8(kb_ + 32 * PITCH + loff); } while (0)
#define SWRITE_HK(bf) do { *(bf16x8*)(K_lds + (bf) * SHM_K + kws) = S.st_k0; *(bf16x8*)(K_lds + (bf) * SHM_K + kws + 32 * 256) = S.st_k1; } while (0)
#define CDMA(Cp, k0, bf) do { if (wid == 0) __builtin_amdgcn_global_load_lds((const unsigned*)((const char*)((Cp) + (size_t)(k0) * 8) + coff), (LAS unsigned*)(C_lds + (bf) * 1024), 16, 0, 0); } while (0)
#define SWRITE_HV(bf) do { *(bf16x8*)(V_lds + (bf) * SHM_V + vst0) = S.st_v0; *(bf16x8*)(V_lds + (bf) * SHM_V + vst1) = S.st_v1; } while (0)
#define SWRITE_H(bf) do { SWRITE_HV(bf); SWRITE_HK(bf); } while (0)
__device__ __forceinline__ void fox_prime(const BlockRef& cur, const Tensors& T, char* lds, Seam& S) {
    const int tid = fresh_tid(), wid = __builtin_amdgcn_readfirstlane(tid >> 6), lane = tid & 63, r32 = lane & 31, hi = lane >> 5;
    const int sr = tid >> 4, sc = (tid & 15) * 8, kws = KSWZ(sr, sc * 2); char* K_lds = lds + 2 * SHM_V; char* C_lds = lds + OFF_C;
    const unsigned loff = (unsigned)(sr * PITCH + sc), qoff = (unsigned)(r32 * PITCH + hi * 8), coff = (unsigned)lane * 16u;
    if (tid < 8) { *(unsigned*)(C_lds + 2048 + (tid & 3) * 4 + (tid >> 2) * 1024) = 0u; }
    { const bf16* qb_ = BR_Q(cur) + (size_t)(wid * cur.wstride) * PITCH;
      for (int d0 = 0; d0 < 8; ++d0) S.qr[d0] = load8(qb_ + qoff + d0 * 16); }
    S.cqf = (bf16x8){0, 0, 0, 0, 0, 0, 0, 0};
    if (hi == 0) S.cqf = load8(BR_CQ(cur) + (size_t)(cur.P0 + wid * cur.wstride) * 8 + (unsigned)(r32 * 8));
    CDMA(BR_CK(cur), cur.jlo * KVBLK, 0);
    SLOAD_H(BR_K(cur), BR_V(cur), 0, cur.jlo * KVBLK); VMW(); SWRITE_HK(0);
    __syncthreads();
}
template <bool SAMP>
__device__ __forceinline__ void fox_block(const BlockRef& cur, const BlockRef& nxt, const Tensors& T, char* lds, Seam& S) {
    const int tid = fresh_tid(), wid = __builtin_amdgcn_readfirstlane(tid >> 6), lane = tid & 63, r32 = lane & 31, hi = lane >> 5;
    const int NT = cur.jhi - cur.jlo, j_lo = cur.jlo;
    const bool act = !SAMP || wid == 0;
#define ACTV(x) do { if (act) { x; } } while (0)
    const int qlo = cur.P0 + wid * cur.wstride, qm = qlo + r32 - 4 * hi;
    char* V_lds = lds; char* K_lds = lds + 2 * SHM_V; char* C_lds = lds + OFF_C;
    float* ws = (float*)(lds + OFF_WS) + wid * 64; float* li_l = ws, * al_l = ws + 32;
    float m_reg = -1e30f, l_reg = 0; f32x16 o[4] = {};
    const int sr = tid >> 4, sc = (tid & 15) * 8, vst0 = v_st(sr, sc), vst1 = v_st(32 + sr, sc), kws = KSWZ(sr, sc * 2);
    const int vb0 = (int)(uintptr_t)V_lds + v_rd_base(lane);
    const int caddr = hi ? 2048 : r32 * 16;
    const unsigned loff = (unsigned)(sr * PITCH + sc), qoff = (unsigned)(r32 * PITCH + hi * 8), coff = (unsigned)lane * 16u;
    const bf16* Kh = BR_K(cur); const bf16* Vh = BR_V(cur); const bf16* Ch = BR_CK(cur); const bf16x8 cqf = S.cqf;
#define RESC(a) do { if (__any((a) < 1.f)) { if (hi == 0) al_l[r32] = (a); asm volatile("s_waitcnt lgkmcnt(0)" ::: "memory");              \
                     for (int d_ = 0; d_ < 4; ++d_) for (int r = 0; r < 16; ++r) o[d_][r] *= al_l[crow(r, hi)]; } } while (0)
#define KBASE(t) ((j_lo + (t)) * KVBLK)
#define MASKT(P0_, P1_, t) do { const int kb_ = KBASE(t); if (kb_ + KVBLK - 1 > qlo) mask_tile(P0_, P1_, qm - kb_); } while (0)
    constexpr int NQL = 9;
#define SEAM_K0() do { VMWN(NQL); SWRITE_HK(0); SBAR(); } while (0)
    f32x16 pA0, pA1, pB0, pB1; float mnA, mnB, alA, alB; bf16x8 pa0, pa1, pa2, pa3;
    SWRITE_HV(0); SBAR();
    if (NT > 1) { CDMA(Ch, KBASE(1), 1); SLOAD_H(Kh, Vh, Ch, KBASE(1)); }
    SBAR(); ACTV(qkt<0>(pA0, pA1, K_lds, C_lds, r32, hi, S.qr, cqf, caddr);
    MASKT(pA0, pA1, 0); partialSM(pA0, pA1, m_reg, mnA, alA));
    if (NT > 1) { VMW(); SWRITE_H(1); }
    __syncthreads();
#define HALF_STEP(PX0, PX1, mnX, alX, PY0, PY1, alY, t, KB, VB, SB) do {                                                      \
        SBAR(); ACTV(qkt<KB>(PX0, PX1, K_lds, C_lds, r32, hi, S.qr, cqf, caddr);                                             \
        finishSM(PY0, PY1, alY, l_reg, pa0, pa1, pa2, pa3)); SBAR();                                                           \
        if ((t) + 1 < NT) { CDMA(Ch, KBASE((t) + 1), SB); SLOAD_H(Kh, Vh, Ch, KBASE((t) + 1)); SBAR(); }                                               \
        ACTV(pv_tile<VB>(o, vb0, pa0, pa1, pa2, pa3); MASKT(PX0, PX1, (t)); partialSM(PX0, PX1, m_reg, mnX, alX));                                        \
        __syncthreads();                                                                                                      \
        if ((t) + 1 < NT) { VMW(); SWRITE_H(SB); }                                                                          \
        ACTV(RESC(alX)); __syncthreads(); } while (0)
    for (int t = 1; t + 1 < NT; t += 2) {
        HALF_STEP(pB0, pB1, mnB, alB, pA0, pA1, alA, t, 1, 0, 0);
        HALF_STEP(pA0, pA1, mnA, alA, pB0, pB1, alB, t + 1, 0, 1, 1);
    }
    const bool even = (NT & 1) == 0;
    if (even) { SBAR(); ACTV(qkt<1>(pB0, pB1, K_lds, C_lds, r32, hi, S.qr, cqf, caddr)); SBAR(); }
    CDMA(BR_CK(nxt), nxt.jlo * KVBLK, 0); SLOAD_H(BR_K(nxt), BR_V(nxt), 0, nxt.jlo * KVBLK); SBAR();
    { const bf16* qb_ = BR_Q(nxt) + (size_t)(wid * nxt.wstride) * PITCH;
#pragma unroll
      for (int d0 = 0; d0 < 8; ++d0) S.qr[d0] = load8(qb_ + qoff + d0 * 16); }
    S.cqf = (bf16x8){0, 0, 0, 0, 0, 0, 0, 0};
    if (hi == 0) S.cqf = load8(BR_CQ(nxt) + (size_t)(nxt.P0 + wid * nxt.wstride) * 8 + (unsigned)(r32 * 8));
    SBAR();
    ACTV(finishSM(pA0, pA1, alA, l_reg, pa0, pa1, pa2, pa3)); SBAR();
    ACTV(pv_tile<0>(o, vb0, pa0, pa1, pa2, pa3));
    if (even) { ACTV(MASKT(pB0, pB1, NT - 1); partialSM(pB0, pB1, m_reg, mnB, alB)); __syncthreads(); ACTV(RESC(alB);
        finishSM(pB0, pB1, alB, l_reg, pa0, pa1, pa2, pa3)); SBAR(); ACTV(pv_tile<1>(o, vb0, pa0, pa1, pa2, pa3)); }
    SBAR(); SEAM_K0();
    if (hi == 0) li_l[r32] = l_reg; asm volatile("s_waitcnt lgkmcnt(0)" ::: "memory");
    float rli[16];
#pragma unroll
    for (int r = 0; r < 16; ++r) rli[r] = __builtin_amdgcn_rcpf(li_l[crow(r, hi)]);
    __syncthreads();
    if (cur.wstride != 0 || wid == 0) {
        bf16* Ow = BR_O(cur) + (size_t)(wid * cur.wstride) * PITCH; char* stg = V_lds + wid * 4096;
        const unsigned srow = (unsigned)(lane >> 3), sch = (unsigned)(lane & 7);
#pragma unroll
        for (int h2 = 0; h2 < 2; ++h2) {
#pragma unroll
            for (int r = 0; r < 16; ++r) { const int orow = crow(r, hi);
#pragma unroll
                for (int d0 = 0; d0 < 2; ++d0) *(bf16*)(stg + orow * 128 + (d0 * 32 + r32) * 2) = (bf16)(cvtpk(o[2 * h2 + d0][r] * rli[r], 0.f) & 0xffffu); }
            asm volatile("s_waitcnt lgkmcnt(0)" ::: "memory");
#pragma unroll
            for (int i = 0; i < 4; ++i) { const unsigned row = i * 8 + srow; const v4u v = *(const v4u*)(stg + row * 128 + sch * 16);
                *(v4u*)(Ow + (size_t)row * PITCH + h2 * 64 + sch * 8) = v; }
            asm volatile("s_waitcnt lgkmcnt(0)" ::: "memory");
        }
    }
    __syncthreads();
#undef ACTV
#undef RESC
#undef KBASE
#undef MASKT
#undef SEAM_K0
#undef HALF_STEP
}
#undef VMW
#undef VMWN
#undef SLOAD_H
#undef SWRITE_HK
#undef SWRITE_HV
#undef SWRITE_H
#undef CDMA
#undef PK4
#undef KSWZ
__device__ __forceinline__ BlockRef fox_ref(int L, int pass, const int* JLO) {
    BlockRef r;
    if (L < 1024) { const int i = L >> 8, v = L & 255, bh = (v >> 5) + 8 * i, j = v & 31, qb = pass == 0 ? 63 - j : j, b = bh >> 4, h = bh & 15;
        r.q0 = (unsigned)((b * SEQ + qb * QB) * PITCH + h * D); r.k0 = (unsigned)(b * SEQ * PITCH + h * D); r.c0 = (unsigned)(bh * SEQ * 8); r.P0 = qb * QB; r.wstride = QBLK; r.jhi = 4 * (qb + 1); r.samp = 0; r.jlo = JLO[bh * (SEQ / QB) + qb]; }
    else { const int s = L - 1024, b = s >> 4, h = s & 15;
        r.q0 = (unsigned)((MP + b * DECT) * PITCH + h * D); r.k0 = (unsigned)(b * KCROWS * PITCH + h * D); r.c0 = (unsigned)(s * KCROWS * 8); r.P0 = PAST; r.wstride = 0; r.jhi = (PAST + DECT + KVBLK - 1) / KVBLK; r.samp = 1; r.jlo = 0; }
    return r;
}
__device__ __forceinline__ void fox_phase(char* lds, const Tensors& T, int vcu, int G) {
    constexpr int TOTAL = 1024 + DECB * FH;
    int L = vcu; if (L >= TOTAL) return;
    int pass = 0;
    BlockRef cur = fox_ref(L, 0, T.JLO);
    Seam S;
    fox_prime(cur, T, lds, S);
    bool done = false;
    while (!cur.samp) {
        const bool more_pass = pass == 0, more_item = L + G < TOTAL, last = !more_pass && !more_item;
        int passn = pass + 1, Ln = L;
        if (!more_pass) { passn = 0; Ln = more_item ? L + G : L; }
        const BlockRef nxt = last ? cur : fox_ref(Ln, passn, T.JLO);
        fox_block<false>(cur, nxt, T, lds, S);
        if (last) { done = true; break; }
        cur = nxt; pass = passn; L = Ln;
    }
    while (!done) {
        const bool more_item = L + G < TOTAL; const int Ln = more_item ? L + G : L;
        const BlockRef nxt = more_item ? fox_ref(Ln, 0, T.JLO) : cur;
        fox_block<true>(cur, nxt, T, lds, S);
        if (!more_item) break;
        cur = nxt; L = Ln;
    }
}
#undef SBAR
#undef BR_Q
#undef BR_O
#undef BR_K
#undef BR_V
#undef BR_CK
#undef BR_CQ
}

namespace swa {
constexpr int NKMAX = 192, LDS_K = 0, LDS_V = NKMAX * 128, LDS_WS = 2 * NKMAX * 128, OST_OFF = 65536, LDS_BYTES = OST_OFF + 8 * 4096;
constexpr float C2 = 0.125f * 1.4426950408889634f, LOG2E = 1.4426950408889634f;
__device__ __forceinline__ int k_off(int row, int chunk) { return row * 128 + ((chunk ^ ((row >> 1) & 7)) << 4); }
__device__ __forceinline__ int v_st(int k, int c) { const int kk = (k & ~0xC) | ((k & 4) << 1) | ((k & 8) >> 1); return ((kk >> 3) * 2 + (c >> 5)) * 512 + ((kk & 7) * 32 + (c & 31)) * 2; }
__device__ __forceinline__ int v_rd_base(int lane) { return ((lane & 3) << 3) | (((lane >> 2) & 3) << 6) | (((lane >> 4) & 1) << 5) | (((lane >> 5) & 1) << 8); }
__device__ __forceinline__ int crow(int r, int hi) { return (r & 3) + 8 * (r >> 2) + 4 * hi; }
struct Tensors { const bf16* Q; const bf16* K; const bf16* V; bf16* O; const bf16* KSC; const bf16* VSC; const float* sinks; };
#define SWA_PK4(P, B_, OUT) do { unsigned a0 = cvtpk(P[B_+0], P[B_+1]), a1 = cvtpk(P[B_+2], P[B_+3]);                          \
        unsigned b0 = cvtpk(P[B_+4], P[B_+5]), b1 = cvtpk(P[B_+6], P[B_+7]);                                             \
        auto r0 = __builtin_amdgcn_permlane32_swap(a0, b0, false, false); auto r1 = __builtin_amdgcn_permlane32_swap(a1, b1, false, false); \
        v4u w = {r0[0], r1[0], r0[1], r1[1]}; OUT = *reinterpret_cast<bf16x8*>(&w); } while (0)
#define SWA_TRRD(dst, off) asm volatile("ds_read_b64_tr_b16 %0, %1 offset:%2" : "=&v"(dst) : "v"(vb0), "i"(off) : "memory")
template <int KB> __device__ __forceinline__ void pv_kb(f32x16* o, const f32x16& p, int vb0) {
    bf16x8 paL, paH; SWA_PK4(p, 0, paL); SWA_PK4(p, 8, paH);
#define SWA_PV_D0(d0) do { s16x4 l0, h0, l1, h1; constexpr int b_ = (d0) * 512 + (2 * KB) * 2048; \
        SWA_TRRD(l0, b_); SWA_TRRD(h0, b_ + 1024); SWA_TRRD(l1, b_ + 2048); SWA_TRRD(h1, b_ + 3072); \
        asm volatile("s_waitcnt lgkmcnt(0)" ::: "memory"); __builtin_amdgcn_sched_barrier(0); \
        o[d0] = __builtin_amdgcn_mfma_f32_32x32x16_bf16(paL, (bf16x8){l0[0], l0[1], l0[2], l0[3], h0[0], h0[1], h0[2], h0[3]}, o[d0], 0, 0, 0); \
        o[d0] = __builtin_amdgcn_mfma_f32_32x32x16_bf16(paH, (bf16x8){l1[0], l1[1], l1[2], l1[3], h1[0], h1[1], h1[2], h1[3]}, o[d0], 0, 0, 0); } while (0)
    SWA_PV_D0(0); SWA_PV_D0(1);
#undef SWA_PV_D0
}
__device__ __forceinline__ void swa_unit(int u, const Tensors& T, char* lds) {
    const int tid = fresh_tid(), wid = __builtin_amdgcn_readfirstlane(tid >> 6), lane = tid & 63, r32 = lane & 31, hi = lane >> 5;
    int ntok, NK, kvh; size_t qrow0; const bf16* Kp; const bf16* Vp;
    if (u < NB * (SEQ / 64) * SKV) { const int b = u / ((SEQ / 64) * SKV), rem = u % ((SEQ / 64) * SKV), c = rem >> 2; kvh = rem & 3;
        const int nprev = c < 2 ? c : 2; ntok = 64; NK = 64 * (nprev + 1); qrow0 = (size_t)b * SEQ + (size_t)c * 64;
        const size_t kr0 = qrow0 - 64 * nprev; Kp = T.K + kr0 * 256 + kvh * 64; Vp = T.V + kr0 * 256 + kvh * 64; }
    else { const int s = u - NB * (SEQ / 64) * SKV, b = s >> 2; kvh = s & 3; ntok = DECT; NK = SROWS; qrow0 = (size_t)MP + (size_t)b * DECT;
        Kp = T.KSC + (size_t)b * SROWS * 256 + kvh * 64; Vp = T.VSC + (size_t)b * SROWS * 256 + kvh * 64; }
    char* K_lds = lds + LDS_K; char* V_lds = lds + LDS_V; float* wsf = (float*)(lds + LDS_WS) + wid * 32;
#pragma unroll
    for (int i = 0; i < 3; ++i) { const int idx = tid + 512 * i, row = idx >> 3, ch = idx & 7;
        bf16x8 kv = {0, 0, 0, 0, 0, 0, 0, 0}, vv = {0, 0, 0, 0, 0, 0, 0, 0};
        if (row < NK) { kv = *(const bf16x8*)(Kp + (size_t)row * 256 + ch * 8); vv = *(const bf16x8*)(Vp + (size_t)row * 256 + ch * 8); }
        *(bf16x8*)(K_lds + k_off(row, ch)) = kv; *(bf16x8*)(V_lds + v_st(row, ch * 8)) = vv; }
    __syncthreads();
    const int vb0 = (int)(uintptr_t)V_lds + v_rd_base(lane);
    const int head = kvh * 8 + wid;
    const float sink2 = T.sinks[head] * LOG2E;
    for (int qb = 0; qb < ntok / 32; ++qb) {
        const bf16* qp = T.Q + (qrow0 + qb * 32 + r32) * DM + head * SHD + hi * 8;
        bf16x8 qf[4];
#pragma unroll
        for (int d0 = 0; d0 < 4; ++d0) qf[d0] = *(const bf16x8*)(qp + d0 * 16);
        f32x16 s[6];
#pragma unroll
        for (int kb = 0; kb < 6; ++kb) {
            if (kb * 32 < NK) {
                s[kb] = f32x16{};
#pragma unroll
                for (int d0 = 0; d0 < 4; ++d0) { const bf16x8 a = *(const bf16x8*)(K_lds + k_off(kb * 32 + r32, d0 * 2 + hi));
                    s[kb] = __builtin_amdgcn_mfma_f32_32x32x16_bf16(a, qf[d0], s[kb], 0, 0, 0); }
            } else {
#pragma unroll
                for (int r = 0; r < 16; ++r) s[kb][r] = -__builtin_inff();
            }
        }
        float mx = s[0][0];
#pragma unroll
        for (int kb = 0; kb < 6; ++kb)
#pragma unroll
            for (int r = 0; r < 16; ++r) mx = fmaxf(mx, s[kb][r]);
        { auto rr = __builtin_amdgcn_permlane32_swap(__float_as_uint(mx), __float_as_uint(mx), false, false); mx = fmaxf(__uint_as_float(rr[0]), __uint_as_float(rr[1])); }
        const float m2 = fmaxf(mx * C2, sink2);
        float ps = 0.f;
#pragma unroll
        for (int kb = 0; kb < 6; ++kb)
#pragma unroll
            for (int r = 0; r < 16; ++r) { const float p = __builtin_amdgcn_exp2f(fmaf(s[kb][r], C2, -m2)); s[kb][r] = p; ps += p; }
        { auto rr = __builtin_amdgcn_permlane32_swap(__float_as_uint(ps), __float_as_uint(ps), false, false); ps = __uint_as_float(rr[0]) + __uint_as_float(rr[1]); }
        const float den = ps + __builtin_amdgcn_exp2f(sink2 - m2);
        f32x16 o[2] = {};
        if (0 * 32 < NK) pv_kb<0>(o, s[0], vb0);
        if (1 * 32 < NK) pv_kb<1>(o, s[1], vb0);
        if (2 * 32 < NK) pv_kb<2>(o, s[2], vb0);
        if (3 * 32 < NK) pv_kb<3>(o, s[3], vb0);
        if (4 * 32 < NK) pv_kb<4>(o, s[4], vb0);
        if (5 * 32 < NK) pv_kb<5>(o, s[5], vb0);
        if (hi == 0) wsf[r32] = den; asm volatile("s_waitcnt lgkmcnt(0)" ::: "memory");
        bf16* Ow = T.O + (qrow0 + qb * 32) * DM + head * SHD; char* stg = lds + OST_OFF + wid * 4096;
#pragma unroll
        for (int r = 0; r < 16; ++r) { const int orow = crow(r, hi); const float rl = __builtin_amdgcn_rcpf(wsf[orow]);
#pragma unroll
            for (int d0 = 0; d0 < 2; ++d0) *(bf16*)(stg + orow * 128 + (d0 * 32 + r32) * 2) = (bf16)(cvtpk(o[d0][r] * rl, 0.f) & 0xffffu); }
        asm volatile("s_waitcnt lgkmcnt(0)" ::: "memory");
#pragma unroll
        for (int i = 0; i < 4; ++i) { const unsigned row = i * 8 + (lane >> 3); const v4u v = *(const v4u*)(stg + row * 128 + (lane & 7) * 16);
            *(v4u*)(Ow + (size_t)row * DM + (lane & 7) * 8) = v; }
        asm volatile("s_waitcnt lgkmcnt(0)" ::: "memory");
    }
    __syncthreads();
}
#undef SWA_PK4
#undef SWA_TRRD
__device__ __forceinline__ void swa_phase(char* lds, const Tensors& T, int vcu, int G) {
    constexpr int TOTAL = NB * (SEQ / 64) * SKV + DECB * SKV;
    for (int u = vcu; u < TOTAL; u += G) swa_unit(u, T, lds);
}
}

namespace sk {
constexpr int ROWB = 272;
constexpr int PART = 64 * ROWB;
constexpr int LDS_BYTES = 131072;
template <bool T> __device__ __forceinline__ size_t op_off(int row, int k, int K) { return T ? tiled_off(row, k, K) : ((size_t)row * K + k) * 2; }
template <int CB, bool AT, bool BT, class Epi>
__device__ __forceinline__ void sk_tile(const bf16* A, const bf16* Bt, int K, char* lds, const Epi& E, int grow0, int brow, int gcol0) {
    static_assert(!BT, "the weight operand of the skinny tiles is row-major");
    constexpr int NB = 2 * CB, BROUNDS = 2 * CB;
    constexpr int SBUF = 65536, SB_OFF = 32768;
    const int tid = fresh_tid(), wid = __builtin_amdgcn_readfirstlane(tid >> 6), lane = tid & 63, fr = lane & 15, fq = lane >> 4;
    const int nst = K >> 8;
    int lrow[4], lch[4]; size_t aoff[4];
#pragma unroll
    for (int j = 0; j < 4; ++j) {
        if (AT) { const int bb = tid * 16 + ((grow0 & 64) ? 8192 : 0), st = bb >> 10, sb = bb & 1023, swz = sb ^ (((sb >> 9) & 1) << 5), R = (st >> 1) * 16 + (swz >> 6), C = (st & 1) * 32 + ((swz & 63) >> 1);
            lrow[j] = R & 63; lch[j] = j * 8 + (C >> 3); aoff[j] = ((size_t)(grow0 >> 7) * (K >> 6) + j) * 16384 + bb; }
        else { const int idx = j * 512 + tid; lrow[j] = idx >> 5; lch[j] = idx & 31; aoff[j] = ((size_t)(grow0 + lrow[j]) * K + lch[j] * 8) * 2; }
    }
    const int brow_l = tid >> 5, bch = tid & 31;
    const char* Ab = (const char*)A; const char* Bb = (const char*)Bt + ((size_t)(brow + brow_l) * K + bch * 8) * 2;
    f32x4 acc[4][NB];
#pragma unroll
    for (int m = 0; m < 4; ++m)
#pragma unroll
        for (int n = 0; n < NB; ++n) acc[m][n] = (f32x4){0.f, 0.f, 0.f, 0.f};
    bf16x8 ra0[4], rb0[BROUNDS], ra1[4], rb1[BROUNDS], ra2[4], rb2[BROUNDS];
#define SK_GLOAD(ra, rb, s) do { if ((s) < nst) { _Pragma("unroll") for (int j = 0; j < 4; ++j) ra[j] = *(const bf16x8*)(Ab + aoff[j] + (size_t)(s) * (AT ? 65536 : 512)); \
        _Pragma("unroll") for (int j = 0; j < BROUNDS; ++j) rb[j] = *(const bf16x8*)(Bb + (size_t)(16 * j) * K * 2 + (size_t)(s) * 512); } } while (0)
#define SK_LWRITE(ra, rb, s) do { if ((s) < nst) { _Pragma("unroll") for (int j = 0; j < 4; ++j) *(bf16x8*)(lds + ((s) & 1) * SBUF + lrow[j] * 512 + ((lch[j] ^ (lrow[j] & 15)) << 4)) = ra[j]; \
        _Pragma("unroll") for (int j = 0; j < BROUNDS; ++j) *(bf16x8*)(lds + ((s) & 1) * SBUF + SB_OFF + (16 * j + brow_l) * 512 + ((bch ^ (brow_l & 15)) << 4)) = rb[j]; } } while (0)
    const int fo = fr * 512 + (((4 * wid + fq) ^ fr) << 4);
#define SK_COMPUTE(s) do { if ((s) < nst) { const char* sa = lds + ((s) & 1) * SBUF + fo; bf16x8 af[4], bfr[NB]; \
        _Pragma("unroll") for (int m = 0; m < 4; ++m) af[m] = *(const bf16x8*)(sa + m * 8192); \
        _Pragma("unroll") for (int n = 0; n < NB; ++n) bfr[n] = *(const bf16x8*)(sa + SB_OFF + n * 8192); \
        _Pragma("unroll") for (int m = 0; m < 4; ++m) _Pragma("unroll") for (int n = 0; n < NB; ++n) acc[m][n] = __builtin_amdgcn_mfma_f32_16x16x32_bf16(bfr[n], af[m], acc[m][n], 0, 0, 0); } } while (0)
    SK_GLOAD(ra0, rb0, 0); SK_GLOAD(ra1, rb1, 1);
    SK_LWRITE(ra0, rb0, 0); __syncthreads();
    for (int s = 0; s < nst; s += 3) {
        SK_GLOAD(ra2, rb2, s + 2); SK_COMPUTE(s);     SK_LWRITE(ra1, rb1, s + 1); __syncthreads();
        SK_GLOAD(ra0, rb0, s + 3); SK_COMPUTE(s + 1); SK_LWRITE(ra2, rb2, s + 2); __syncthreads();
        SK_GLOAD(ra1, rb1, s + 4); SK_COMPUTE(s + 2); SK_LWRITE(ra0, rb0, s + 3); __syncthreads();
    }
#undef SK_GLOAD
#undef SK_LWRITE
#undef SK_COMPUTE
    char* pw = lds + (wid & 3) * PART;
#define SK_AT(m, n) (pw + (16 * (m) + fr) * ROWB + (16 * (n) + 4 * fq) * 4)
    if (wid >= 4) {
#pragma unroll
        for (int m = 0; m < 4; ++m)
#pragma unroll
            for (int n = 0; n < NB; ++n) *(f32x4*)SK_AT(m, n) = acc[m][n]; }
    __syncthreads();
    if (wid < 4) {
#pragma unroll
        for (int m = 0; m < 4; ++m)
#pragma unroll
            for (int n = 0; n < NB; ++n) acc[m][n] += *(const f32x4*)SK_AT(m, n); }
    __syncthreads();
    if (wid < 4) {
#pragma unroll
        for (int m = 0; m < 4; ++m)
#pragma unroll
            for (int n = 0; n < NB; ++n) *(f32x4*)SK_AT(m, n) = acc[m][n]; }
    __syncthreads();
#undef SK_AT
    { const int row = tid >> 3, cg = (tid & 7) * 4 * CB; f32x4 v[CB];
#pragma unroll
        for (int c = 0; c < CB; ++c) { v[c] = *(const f32x4*)(lds + row * ROWB + (cg + 4 * c) * 4);
#pragma unroll
            for (int p = 1; p < 4; ++p) v[c] += *(const f32x4*)(lds + p * PART + row * ROWB + (cg + 4 * c) * 4); }
        E(grow0 + row, gcol0 + cg, v); }
    __syncthreads();
}
template <int CB, bool AT, bool BT, class Epi>
__device__ __forceinline__ void sk_gemm(const bf16* A, int row0, int nrt, const bf16* Bt, int brow0, int nct, int K, char* lds, const Epi& E, int vcu, int G, int rot = 0) {
    for (int t = (vcu + G - rot % G) % G; t < nrt * nct; t += G) { const int rt = t % nrt, ct = t / nrt;
        sk_tile<CB, AT, BT, Epi>(A, Bt, K, lds, E, row0 + 64 * rt, brow0 + 32 * CB * ct, 32 * CB * ct); }
}
__device__ __forceinline__ v4u pack8(f32x4 a, f32x4 b) { return (v4u){cvtpk(a[0], a[1]), cvtpk(a[2], a[3]), cvtpk(b[0], b[1]), cvtpk(b[2], b[3])}; }
struct SkFoxIn {
    bf16 *Q, *K, *V, *KC, *VC; float* out;
    __device__ __forceinline__ void operator()(int row, int col, const f32x4 (&v)[2]) const {
        const int kind = col >> 11, c = col & 2047, rs = row - MP, b = rs >> 5, t = rs & 31; const v4u w = pack8(v[0], v[1]);
        if (kind == 0) { *(v4u*)(Q + (size_t)row * DM + c) = w; }
        else { bf16* T = kind == 1 ? K : V; bf16* C = kind == 1 ? KC : VC; float* o = out + (kind == 1 ? O_FKS : O_FVS) + (size_t)rs * DM + c;
            *(v4u*)(T + (size_t)row * DM + c) = w; *(v4u*)(C + ((size_t)b * KCROWS + PAST + t) * DM + c) = w; *(f32x4*)o = v[0]; *(f32x4*)(o + 4) = v[1]; }
    }
};
struct SkGates {
    float* out; const float* bfg; float* lfh;
    __device__ __forceinline__ void operator()(int row, int col, const f32x4 (&v)[1]) const {
        if (col < FH) { const f32x4 b4 = *(const f32x4*)(bfg + col); f32x4 o;
#pragma unroll
            for (int e = 0; e < 4; ++e) { const float z = v[0][e] + b4[e]; o[e] = fminf(z, 0.f) - log1pf(__expf(-fabsf(z))); }
            float* dst = row < MP ? out + O_FLP + (size_t)row * FH : out + O_FLS + (size_t)(row - MP) * FH;
            *(f32x4*)(dst + col) = o;
            if (row < MP) { float* lp = lfh + ((size_t)(row >> 14) * FH + col) * SEQ + (row & (SEQ - 1));
#pragma unroll
                for (int e = 0; e < 4; ++e) lp[(size_t)e * SEQ] = o[e]; } }
    }
};
template <bool FUSE> struct SkResid {
    const float* base; float* X; const float* gate;
    const float* ng; const float* nsc; bf16* H; float* rss;
    __device__ __forceinline__ void operator()(int row, int col, const f32x4 (&v)[2]) const {
        const int rs = row - MP, ar = 2 + (rs >> 5); const float* gp = gate + (size_t)ar * ADAW + col; const float* bp = base + (size_t)rs * DM + col; float* xp = X + (size_t)rs * DM + col;
        const f32x4 g0 = *(const f32x4*)gp, g1 = *(const f32x4*)(gp + 4), b0 = *(const f32x4*)bp, b1 = *(const f32x4*)(bp + 4);
        const f32x4 x0 = b0 + g0 * v[0], x1 = b1 + g1 * v[1];
        *(f32x4*)xp = x0; *(f32x4*)(xp + 4) = x1;
        if (FUSE) { const float* sp = nsc + (size_t)ar * ADAW + col;
            const f32x4 c0 = *(const f32x4*)(ng + col) * (*(const f32x4*)sp + 1.0f), c1 = *(const f32x4*)(ng + col + 4) * (*(const f32x4*)(sp + 4) + 1.0f);
            *(v4u*)((char*)H + tiled_off(row, col, DM)) = pack8(x0 * c0, x1 * c1);
            float ss = ((x0[0] * x0[0] + x0[1] * x0[1]) + (x0[2] * x0[2] + x0[3] * x0[3])) + ((x1[0] * x1[0] + x1[1] * x1[1]) + (x1[2] * x1[2] + x1[3] * x1[3]));
            ss += __shfl_xor(ss, 1); ss += __shfl_xor(ss, 2); ss += __shfl_xor(ss, 4);
            if ((col & 63) == 0) (void)__hip_atomic_fetch_add(rss + row, ss, __ATOMIC_RELAXED, __HIP_MEMORY_SCOPE_AGENT); }
    }
};
struct SkUp {
    bf16* Ah; const float* rss; const float* sw;
    __device__ __forceinline__ void operator()(int row, int col, const f32x4 (&v)[2]) const {
        const float rstd = 1.0f / sqrtf(rss[row] * (1.0f / DM) + RMS_EPS); const float* swp = sw + (size_t)(2 + ((row - MP) >> 5)) * DFF + col;
        f32x4 a = v[0] * rstd + *(const f32x4*)swp, b = v[1] * rstd + *(const f32x4*)(swp + 4);
#pragma unroll
        for (int e = 0; e < 4; ++e) { const float x = fmaxf(a[e], 0.f), y = fmaxf(b[e], 0.f); a[e] = x * x; b[e] = y * y; }
        *(v4u*)(Ah + (size_t)row * DFF + col) = pack8(a, b);
    }
};
struct SkSW {
    float* SW; int N;
    __device__ __forceinline__ void operator()(int row, int col, const f32x4 (&v)[2]) const {
        if (row < NADA) { float* o = SW + (size_t)row * N + col; *(f32x4*)o = v[0]; *(f32x4*)(o + 4) = v[1]; }
    }
};
struct SkSwaIn {
    bf16 *Q, *K, *V, *KSC, *VSC; float* out; const float* rope; const float* rss; const float* sw;
    __device__ __forceinline__ void operator()(int row, int col, const f32x4 (&vin)[2]) const {
        const int kind = col < DM ? 0 : (col < DM + 256 ? 1 : 2), rs = row - MP, b = rs >> 5, t = rs & 31;
        const float rstd = 1.0f / sqrtf(rss[row] * (1.0f / DM) + RMS_EPS); const float* swp = sw + (size_t)(2 + b) * SWA_IN + col;
        f32x4 v0 = vin[0] * rstd + *(const f32x4*)swp, v1 = vin[1] * rstd + *(const f32x4*)(swp + 4);
        { f32x4 p0, p1;
#pragma unroll
            for (int e = 0; e < 4; ++e) { p0[e] = __shfl_xor(v0[e], 1); p1[e] = __shfl_xor(v1[e], 1); }
            if (kind != 2 && (col & 63) < 16) { const float* rp = rope + (size_t)(PAST + t) * 16;
                const f32x4 c0 = *(const f32x4*)rp, c1 = *(const f32x4*)(rp + 4), s0 = *(const f32x4*)(rp + 8), s1 = *(const f32x4*)(rp + 12);
                if ((col & 8) == 0) { v0 = v0 * c0 - p0 * s0; v1 = v1 * c1 - p1 * s1; } else { v0 = v0 * c0 + p0 * s0; v1 = v1 * c1 + p1 * s1; } } }
        const v4u w = pack8(v0, v1);
        if (kind == 0) { *(v4u*)(Q + (size_t)row * DM + col) = w; }
        else { const int c = (col - DM) & 255; bf16* T = kind == 1 ? K : V; bf16* C = kind == 1 ? KSC : VSC; float* o = out + (kind == 1 ? O_SKS : O_SVS) + ((size_t)b * WBUF + (WBUF - DECT) + t) * 256 + c;
            *(v4u*)(T + (size_t)row * 256 + c) = w; *(v4u*)(C + ((size_t)b * SROWS + WBUF + t) * 256 + c) = w; *(f32x4*)o = v0; *(f32x4*)(o + 4) = v1; }
    }
};
}
#define XB_TMO      128
#define XB_XCNT(j)  (256  + 64 * (j))
#define XB_XSUB(j)  (1280 + 64 * (j))
#define XB_XGEN(j)  (2304 + 64 * (j))
#define XB_TOP      3328
#define XB_TOPGEN   3392
#define XCD_BAR_WORDS 3456
#define XB_SPIN_CAP (1u << 18)

__device__ __forceinline__ unsigned xb_ld(unsigned* p)              { return __hip_atomic_load(p, __ATOMIC_RELAXED, __HIP_MEMORY_SCOPE_AGENT); }
__device__ __forceinline__ unsigned xb_add(unsigned* p, unsigned v) { return __hip_atomic_fetch_add(p, v, __ATOMIC_RELAXED, __HIP_MEMORY_SCOPE_AGENT); }
__device__ __forceinline__ unsigned xb_xcc_id() { return (unsigned)__builtin_amdgcn_s_getreg((3 << 11) | 20) & 0xFu; }
#define XB_SPIN(cond, bar) do { unsigned _sp = 0; while (cond) { __builtin_amdgcn_s_sleep(1); \
    if ((++_sp & 255u) == 0u) { if (xb_ld(&(bar)[XB_TMO])) break; if (_sp > XB_SPIN_CAP) { atomicAdd(&(bar)[XB_TMO], 1u); break; } } } } while (0)

struct XcdBarrier {
    unsigned* bar; unsigned x;
    volatile LAS unsigned* st;
};

__device__ __forceinline__ XcdBarrier xcd_barrier_post(unsigned* bar, volatile LAS unsigned* st) {
    XcdBarrier b; b.bar = bar; b.x = xb_xcc_id(); b.st = st;
    if (threadIdx.x == 0) (void)xb_add(&bar[XB_XCNT(b.x)], 1u);
    return b;
}
__device__ __forceinline__ void xcd_barrier_complete(unsigned* bar, unsigned x, unsigned& nloc, unsigned& nx) {
    const unsigned G = gridDim.x * gridDim.y * gridDim.z;
    unsigned sum, cnt, mine, sp = 0u;
    for (;;) {
        sum = 0u; cnt = 0u; mine = 0u;
#pragma unroll
        for (unsigned j = 0; j < 16; ++j) { const unsigned c = xb_ld(&bar[XB_XCNT(j)]); sum += c; cnt += (c > 0u) ? 1u : 0u; mine = (j == x) ? c : mine; }
        if (sum == G) break;
        __builtin_amdgcn_s_sleep(1);
        if ((++sp & 255u) == 0u) { if (xb_ld(&bar[XB_TMO])) break; if (sp > XB_SPIN_CAP) { atomicAdd(&bar[XB_TMO], 1u); break; } }
    }
    nloc = mine > 0u ? mine : 1u; nx = cnt > 0u ? cnt : 1u;
}

__device__ __forceinline__ void xcd_barrier(const XcdBarrier& b) {
    asm volatile("s_waitcnt vmcnt(0)" ::: "memory");
    __syncthreads();
    if (threadIdx.x == 0) {
        unsigned* bar = b.bar;
        __builtin_amdgcn_s_waitcnt(0);
        unsigned nloc = b.st[0], nx = b.st[1];
        if (nloc == 0u) { xcd_barrier_complete(bar, b.x, nloc, nx); b.st[0] = nloc; b.st[1] = nx; }
        const unsigned old = xb_add(&bar[XB_XSUB(b.x)], 1u);
        const unsigned gen = old / nloc;
        if (old + 1u == (gen + 1u) * nloc) {
            __builtin_amdgcn_fence(__ATOMIC_RELEASE, "agent");
            asm volatile("s_waitcnt vmcnt(0)" ::: "memory");
            const unsigned og = xb_add(&bar[XB_TOP], 1u);
            const unsigned tg = og / nx;
            if (og + 1u == (tg + 1u) * nx) xb_add(&bar[XB_TOPGEN], 1u);
            else XB_SPIN(xb_ld(&bar[XB_TOPGEN]) == tg, bar);
            __builtin_amdgcn_fence(__ATOMIC_ACQUIRE, "agent");
            xb_add(&bar[XB_XGEN(b.x)], 1u);
            asm volatile("s_waitcnt vmcnt(0)" ::: "memory");
        } else {
            XB_SPIN(xb_ld(&bar[XB_XGEN(b.x)]) == gen, bar);
            __builtin_amdgcn_fence(__ATOMIC_ACQUIRE, "agent");
            asm volatile("s_waitcnt vmcnt(0)" ::: "memory");
        }
    }
    __syncthreads();
}

constexpr int NWAVES = 8;
constexpr int RING_OFF = 0, RING_BYTES = 131072, LDSCTL_OFF = RING_BYTES, MISC_OFF = LDSCTL_OFF + 320, LDS_BYTES = 147456;
static_assert(fox::LDS_BYTES <= RING_BYTES && swa::LDS_BYTES <= RING_BYTES && MISC_OFF + 128 <= LDS_BYTES, "LDS map");

struct Args { const float* in[22]; float* out; unsigned char* ws; int ph_lo, ph_hi, li, pad; };
struct Frame { int tid, lane, wave, vcu, G; };
typedef const __attribute__((address_space(4))) Args* KA;
__device__ __forceinline__ KA fresh_args() { KA p = (KA)__builtin_amdgcn_kernarg_segment_ptr(); asm volatile("" : "+s"(p)); return p; }

__device__ __forceinline__ float wave_sum(float v) {
#pragma unroll
    for (int o = 1; o < 64; o <<= 1) v += __shfl_xor(v, o);
    return v;
}

__device__ __forceinline__ void p0_transpose_item(const float* W, int K, int ldw, int nvalid, int nblk, bf16* WT, LAS float* scr, int item, int lane) {
    const int kb = item / nblk, nb = item % nblk, k0 = 64 * kb, n0 = 32 * nb;
    const int ncol = n0 + (lane & 31); const bool ok = ncol < nvalid;
    const float* wp = W + (size_t)(k0 + (lane >> 5)) * ldw + (ok ? ncol : 0);
#pragma unroll
    for (int h = 0; h < 2; ++h) {
        float t[16];
#pragma unroll
        for (int i = 0; i < 16; ++i) t[i] = wp[(size_t)(2 * (16 * h + i)) * ldw];
#pragma unroll
        for (int i = 0; i < 16; ++i) scr[(2 * (16 * h + i) + (lane >> 5)) * 33 + (lane & 31)] = ok ? t[i] : 0.f;
    }
    LDS_WAIT(); asm volatile("" ::: "memory");
    const int c = lane & 7;
#pragma unroll
    for (int j = 0; j < 4; ++j) { const int n = (lane >> 3) + 8 * j; const LAS float* s = scr + (8 * c) * 33 + n;
        v4u o; o.x = cvtpk(s[0 * 33], s[1 * 33]); o.y = cvtpk(s[2 * 33], s[3 * 33]); o.z = cvtpk(s[4 * 33], s[5 * 33]); o.w = cvtpk(s[6 * 33], s[7 * 33]);
        *(GAS v4u*)(WT + (size_t)(n0 + n) * K + k0 + 8 * c) = o; }
    LDS_WAIT(); asm volatile("" ::: "memory");
}
__device__ __forceinline__ void cvt_row_bf16(const float* src, bf16* dst, int lane) {
    const GAS f32x4* xr = (const GAS f32x4*)src + lane; GAS v2u* o8 = (GAS v2u*)dst + lane;
    f32x4 v[8];
#pragma unroll
    for (int j = 0; j < 8; ++j) v[j] = xr[64 * j];
#pragma unroll
    for (int j = 0; j < 8; ++j) { v2u w; w.x = cvtpk(v[j][0], v[j][1]); w.y = cvtpk(v[j][2], v[j][3]); o8[64 * j] = w; }
}
__device__ __forceinline__ void sincos_d(double a, double& s, double& c) {
    const double n = __builtin_rint(a * 0.6366197723675814);
    double r = __builtin_fma(-n, 1.5707963267948966, a); r = __builtin_fma(-n, 6.123233995736766e-17, r);
    const double r2 = r * r;
    double ps = -7.6471637318198164759e-13; ps = ps * r2 + 1.6059043836821614599e-10; ps = ps * r2 - 2.5052108385441718775e-8; ps = ps * r2 + 2.7557319223985890653e-6;
    ps = ps * r2 - 1.9841269841269841270e-4; ps = ps * r2 + 8.3333333333333333333e-3; ps = ps * r2 - 1.6666666666666666667e-1; ps = r + r * r2 * ps;
    double pc = 4.7794773323873852974e-14; pc = pc * r2 - 1.1470745597729724714e-11; pc = pc * r2 + 2.0876756987868098979e-9; pc = pc * r2 - 2.7557319223985890653e-7;
    pc = pc * r2 + 2.4801587301587301587e-5; pc = pc * r2 - 1.3888888888888888889e-3; pc = pc * r2 + 4.1666666666666666667e-2; pc = pc * r2 - 0.5; pc = 1.0 + r2 * pc;
    const int q = (int)n & 3;
    s = (q == 0) ? ps : (q == 1) ? pc : (q == 2) ? -ps : -pc;
    c = (q == 0) ? pc : (q == 1) ? -ps : (q == 2) ? -pc : ps;
}

__device__ __forceinline__ void p0_ada(KA a, const Frame& F, LAS unsigned char* lds) {
    LAS float* sS = (LAS float*)lds;
    LAS float* red = (LAS float*)(lds + 36864);
    const float* cP = a->in[2]; const float* cS = a->in[3]; const float* W = a->in[9]; const float* Bv = a->in[10];
    float* ADA = (float*)(a->ws + WS_ADA);
    const int half = F.lane >> 5, cl = (F.lane & 31) * 4;
    for (int task = F.vcu; task < 2 * (ADAW / 128); task += F.G) {
        const int l = task / (ADAW / 128), n0 = (task % (ADAW / 128)) * 128;
        const float* Wl = W + (size_t)l * DM * ADAW + n0 + cl;
        f32x4 acc[NADA];
#pragma unroll
        for (int r = 0; r < NADA; ++r) acc[r] = (f32x4){0.f, 0.f, 0.f, 0.f};
        for (int stage = 0; stage < 4; ++stage) {
            __syncthreads();
            for (int idx = F.tid; idx < NADA * 512; idx += NWAVES * 64) { const int r = idx >> 9, k = idx & 511;
                const float cv = r < 2 ? cP[r * DM + stage * 512 + k] : cS[(r - 2) * DM + stage * 512 + k];
                sS[idx] = cv / (1.f + __expf(-cv)); }
            __syncthreads();
            const int kw = F.wave * 64;
#pragma unroll 1
            for (int i0 = 0; i0 < 32; i0 += 8) {
                f32x4 wv[8];
#pragma unroll
                for (int i = 0; i < 8; ++i) wv[i] = *(const f32x4*)(Wl + (size_t)(stage * 512 + kw + 2 * (i0 + i) + half) * ADAW);
#pragma unroll
                for (int i = 0; i < 8; ++i) { const int k = kw + 2 * (i0 + i) + half;
#pragma unroll
                    for (int r = 0; r < NADA; ++r) acc[r] += wv[i] * sS[r * 512 + k]; }
            }
        }
#pragma unroll
        for (int hh = 0; hh < 2; ++hh) {
            __syncthreads();
#pragma unroll
            for (int r = 0; r < 9; ++r) *(LAS f32x4*)(red + ((F.wave * 2 + half) * 9 + r) * 128 + cl) = acc[9 * hh + r];
            __syncthreads();
            for (int idx = F.tid; idx < 9 * 128; idx += NWAVES * 64) { const int r = idx >> 7, c = idx & 127; float s = 0.f;
#pragma unroll
                for (int p = 0; p < 16; ++p) s += red[(p * 9 + r) * 128 + c];
                ADA[((size_t)l * NADA + 9 * hh + r) * ADAW + n0 + c] = s + Bv[(size_t)l * ADAW + n0 + c]; }
        }
    }
    __syncthreads();
}

constexpr int I_FIN = 32 * (FOX_IN_PAD / 32), I_SQ = 32 * 64, I_SIN = 32 * (SWA_IN / 32), I_UP = 32 * (DFF / 32), I_DN = (DFF / 64) * 64;
constexpr int NITEMS = I_FIN + 2 * I_SQ + I_SIN + 2 * I_UP + 2 * I_DN;
__device__ __forceinline__ void p0_copies(KA a, LAS unsigned char* lds, int wave, int lane, int first, int it0, int it1, int gw, int NGW, bool caches) {
    unsigned char* ws = a->ws;
    LAS float* scr = (LAS float*)(lds + wave * 16384);
    for (int it = it0 + first; it < it1; it += NGW) {
        int r = it;
        if (r < I_FIN) { p0_transpose_item(a->in[13], DM, FOX_IN, FOX_IN, FOX_IN_PAD / 32, (bf16*)(ws + WS_WFIN), scr, r, lane); continue; } r -= I_FIN;
        if (r < I_SQ) { p0_transpose_item(a->in[15], DM, DM, DM, 64, (bf16*)(ws + WS_WFOUT), scr, r, lane); continue; } r -= I_SQ;
        if (r < I_SIN) { p0_transpose_item(a->in[16], DM, SWA_IN, SWA_IN, SWA_IN / 32, (bf16*)(ws + WS_WSIN), scr, r, lane); continue; } r -= I_SIN;
        if (r < I_SQ) { p0_transpose_item(a->in[18], DM, DM, DM, 64, (bf16*)(ws + WS_WSOUT), scr, r, lane); continue; } r -= I_SQ;
        if (r < 2 * I_UP) { const int l = r / I_UP; p0_transpose_item(a->in[19] + (size_t)l * DM * DFF, DM, DFF, DFF, DFF / 32, (bf16*)(ws + WS_WUP) + (size_t)l * DM * DFF, scr, r % I_UP, lane); continue; } r -= 2 * I_UP;
        { const int l = r / I_DN; p0_transpose_item(a->in[20] + (size_t)l * DM * DFF, DFF, DM, DM, 64, (bf16*)(ws + WS_WDN) + (size_t)l * DM * DFF, scr, r % I_DN, lane); }
    }
    if (caches) for (int it = gw; it < 2 * DECB * KCROWS; it += NGW) {
        const int kv = it / (DECB * KCROWS), rem = it % (DECB * KCROWS), b = rem / KCROWS, p = rem % KCROWS;
        bf16* dst = (bf16*)(ws + (kv ? WS_VC : WS_KC)) + ((size_t)b * KCROWS + p) * DM;
        if (p < PAST) cvt_row_bf16(a->in[kv ? 5 : 4] + ((size_t)b * PAST + p) * DM, dst, lane);
        else if (p >= PAST + DECT) { GAS v2u* o8 = (GAS v2u*)dst + lane;
#pragma unroll
            for (int j = 0; j < 8; ++j) o8[64 * j] = (v2u){0u, 0u}; }
    }
}
constexpr int NWORK = 4;
__device__ __forceinline__ void p0_prologue(KA a, const Frame& F, LAS unsigned char* lds) {
    unsigned char* ws = a->ws;
    p0_ada(a, F, lds);
    const int gw = F.vcu * NWAVES + F.wave, NGW = F.G * NWAVES;
    const int irot = NGW > 2 * (ADAW / 128) * NWAVES ? 2 * (ADAW / 128) * NWAVES : 0;
    const bool split = (F.G % 8 == 0) && (F.G / 8 > NWORK);
    p0_copies(a, lds, F.wave, F.lane, (gw + NGW - irot) % NGW, 0, split ? I_FIN : NITEMS, gw, NGW, !split);
    const int gt = (F.vcu * NWAVES + F.wave) * 64 + F.lane, NGT = NGW * 64;
    float* rope = (float*)(ws + WS_ROPE);
    for (int e = gt; e < SEQ * 8; e += NGT) { const int pos = e >> 3, i = e & 7;
        const double inv = i == 0 ? 1.0 : i == 1 ? 0.19392274474868576 : i == 2 ? 0.03760603093086393 : i == 3 ? 0.007292664737217109 : i == 4 ? 0.001414213562373095 :
                           i == 5 ? 0.0002742481756762073 : i == 6 ? 5.318295896944988e-05 : 1.031338537721246e-05;
        double s, c; sincos_d((double)pos * inv, s, c); rope[pos * 16 + i] = (float)c; rope[pos * 16 + 8 + i] = (float)s; }
    for (int e = gt; e < 2 * DECB * WBUF * 256; e += NGT) { const int kv = e / (DECB * WBUF * 256), rem = e % (DECB * WBUF * 256), b = rem / (WBUF * 256), p = (rem / 256) % WBUF, c = rem & 255;
        const float v = a->in[kv ? 8 : 7][rem];
        ((bf16*)(ws + (kv ? WS_VSC : WS_KSC)))[((size_t)b * SROWS + p) * 256 + c] = (bf16)(cvtpk(v, 0.f) & 0xffffu);
        if (p >= DECT) a->out[(kv ? O_SVS : O_SKS) + ((size_t)b * WBUF + (p - DECT)) * 256 + c] = v; }
}

__device__ __forceinline__ void norm_rows(const float* xP, const float* xS, const float* g, const float* ada_l, int shift_idx, bf16* H, const Frame& F) {
    const int gw = F.vcu * NWAVES + F.wave, NGW = F.G * NWAVES;
    for (int blk = gw; blk < MP / 16 + MS; blk += NGW) {
        const int row0 = blk < MP / 16 ? blk * 16 : MP + (blk - MP / 16), nrows = blk < MP / 16 ? 16 : 1;
        const float* ap = ada_l + (size_t)arow_of(row0) * ADAW + shift_idx * DM;
        f32x4 mul[8], add[8];
#pragma unroll
        for (int j = 0; j < 8; ++j) { const int c = 4 * F.lane + 256 * j; const f32x4 gv = *(const f32x4*)(g + c), sc = *(const f32x4*)(ap + DM + c); add[j] = *(const f32x4*)(ap + c); mul[j] = gv * (sc + 1.0f); }
        for (int rr = 0; rr < nrows; ++rr) { const int row = row0 + rr;
            const GAS f32x4* xr = (const GAS f32x4*)(row < MP ? xP + (size_t)row * DM : xS + (size_t)(row - MP) * DM) + F.lane;
            f32x4 v[8]; float ss = 0.f;
#pragma unroll
            for (int j = 0; j < 8; ++j) { v[j] = xr[64 * j]; ss += (v[j][0] * v[j][0] + v[j][1] * v[j][1]) + (v[j][2] * v[j][2] + v[j][3] * v[j][3]); }
            const float rstd = 1.0f / sqrtf(wave_sum(ss) * (1.0f / DM) + RMS_EPS);
            const size_t o0 = tiled_off(row, 4 * F.lane, DM);
#pragma unroll
            for (int j = 0; j < 8; ++j) { const f32x4 h = (v[j] * rstd) * mul[j] + add[j]; v2u w; w.x = cvtpk(h[0], h[1]); w.y = cvtpk(h[2], h[3]); *(GAS v2u*)((GAS char*)H + o0 + (size_t)j * 65536) = w; }
        }
    }
}
__device__ __forceinline__ void fill_shift_rows(const float* ADA, bf16* SH, const Frame& F) {
    const int gt = (F.vcu * NWAVES + F.wave) * 64 + F.lane, NGT = F.G * NWAVES * 64;
    for (int e = gt; e < 3 * 64 * DM; e += NGT) { const int c = e / (64 * DM), r = (e / DM) & 63, k = e & (DM - 1);
        const float* sh = ADA + (c == 0 ? 3 * DM : (c == 1 ? NADA * ADAW : NADA * ADAW + 3 * DM));
        SH[e] = r < NADA ? (bf16)(cvtpk(sh[(size_t)r * ADAW + k], 0.f) & 0xffffu) : (bf16)0; }
}
__device__ __forceinline__ void final_norm(float* X, const float* g, const Frame& F) {
    const int gw = F.vcu * NWAVES + F.wave, NGW = F.G * NWAVES;
    f32x4 gv[8];
#pragma unroll
    for (int j = 0; j < 8; ++j) gv[j] = *(const f32x4*)(g + 4 * F.lane + 256 * j);
    for (int row = gw; row < MT; row += NGW) {
        GAS f32x4* xr = (GAS f32x4*)(X + (size_t)row * DM) + F.lane;
        f32x4 v[8]; float ss = 0.f;
#pragma unroll
        for (int j = 0; j < 8; ++j) { v[j] = xr[64 * j]; ss += (v[j][0] * v[j][0] + v[j][1] * v[j][1]) + (v[j][2] * v[j][2] + v[j][3] * v[j][3]); }
        const float rstd = 1.0f / sqrtf(wave_sum(ss) * (1.0f / DM) + RMS_EPS);
#pragma unroll
        for (int j = 0; j < 8; ++j) xr[64 * j] = (v[j] * rstd) * gv[j];
    }
}
__device__ __forceinline__ void bias_rows(float x, bf16* ck, bf16* cq) {
    const unsigned c1 = cvtpk(x, 0.f) & 0xffffu; const float r1 = x - __uint_as_float(c1 << 16);
    const unsigned c2 = cvtpk(r1, 0.f) & 0xffffu; const float r2 = r1 - __uint_as_float(c2 << 16);
    const unsigned c3 = cvtpk(r2, 0.f) & 0xffffu;
    const unsigned one = 0x3F80u;
    *(GAS v4u*)ck = (v4u){(c1 ^ 0x8000u) | ((c2 ^ 0x8000u) << 16), (c3 ^ 0x8000u) | (one << 16), one | (one << 16), 0u};
    *(GAS v4u*)cq = (v4u){one | (one << 16), one | (c1 << 16), c2 | (c3 << 16), 0u};
}
__device__ __forceinline__ void fox_norms(const bf16* Q, const bf16* K, float* QN, float* KN, float* SD, const Frame& F) {
    const int gw = F.vcu * NWAVES + F.wave, NGW = F.G * NWAVES;
    for (int row = gw; row < MP; row += NGW) {
        const GAS v4u* qp = (const GAS v4u*)(Q + (size_t)row * DM) + 4 * F.lane; const GAS v4u* kp = (const GAS v4u*)(K + (size_t)row * DM) + 4 * F.lane;
        v4u qv[4], kv[4];
#pragma unroll
        for (int j = 0; j < 4; ++j) { qv[j] = qp[j]; kv[j] = kp[j]; }
        float qq = 0.f, kk = 0.f, qk = 0.f;
#pragma unroll
        for (int j = 0; j < 4; ++j)
#pragma unroll
            for (int e = 0; e < 4; ++e) { const float q0 = __uint_as_float(qv[j][e] << 16), q1 = __uint_as_float(qv[j][e] & 0xffff0000u), k0 = __uint_as_float(kv[j][e] << 16), k1 = __uint_as_float(kv[j][e] & 0xffff0000u);
                qq += q0 * q0 + q1 * q1; kk += k0 * k0 + k1 * k1; qk += q0 * k0 + q1 * k1; }
        qq += __shfl_xor(qq, 1); kk += __shfl_xor(kk, 1); qk += __shfl_xor(qk, 1);
        qq += __shfl_xor(qq, 2); kk += __shfl_xor(kk, 2); qk += __shfl_xor(qk, 2);
        if ((F.lane & 3) == 0) { const size_t ix = ((size_t)(row >> 14) * FH + (F.lane >> 2)) * SEQ + (row & (SEQ - 1)); QN[ix] = qq; KN[ix] = kk; SD[ix] = qk * 0.08838834764831845f; }
    }
}
constexpr float PRUNE_EPS = 2.9802322e-8f;
__device__ __forceinline__ void fox_scan(KA a, const Frame& F, LAS unsigned char* lds) {
    LAS double* sd = (LAS double*)lds;
    LAS float* s_cend = (LAS float*)(lds + 8192);
    LAS float* s_kpre = (LAS float*)(lds + 10240);
    LAS float* s_qmax = (LAS float*)(lds + 14336);
    LAS float* s_sdmin = (LAS float*)(lds + 16384);
    LAS float* stg = (LAS float*)(lds + 20480);
    const float* QN = (const float*)(a->ws + WS_QN); const float* KN = (const float*)(a->ws + WS_KN); const float* SD = (const float*)(a->ws + WS_SD); const float* LFH = (const float*)(a->ws + WS_LFH);
    int* JLO = (int*)(a->ws + WS_JLO);
    const float* lsm = a->out + O_FLS; const float* lc = a->in[6];
    const int tid = F.tid;
    for (int task = F.vcu; task < NB * FH + DECB * FH; task += F.G) {
        if (task < NB * FH) {
            const int s = task; const size_t sb = (size_t)s * SEQ;
            bf16* dk = (bf16*)(a->ws + WS_CKP) + sb * 8; bf16* dq = (bf16*)(a->ws + WS_CQP) + sb * 8;
#define SCAN_STAGE(SRC) do { __syncthreads(); f32x4 t_[8]; _Pragma("unroll") for (int k = 0; k < 8; ++k) t_[k] = *(const f32x4*)((SRC) + sb + (size_t)(k * 512 + tid) * 4); \
            _Pragma("unroll") for (int k = 0; k < 8; ++k) { const int p = (k * 512 + tid) * 4, q_ = p + (p >> 5); stg[q_] = t_[k][0]; stg[q_ + 1] = t_[k][1]; stg[q_ + 2] = t_[k][2]; stg[q_ + 3] = t_[k][3]; } __syncthreads(); } while (0)
            float kmx = 0.f, qmx = 0.f, sdm = 3.0e38f; double loc = 0.0;
            SCAN_STAGE(KN);
#pragma unroll 8
            for (int i = 0; i < 32; ++i) kmx = fmaxf(kmx, stg[33 * tid + i]);
            SCAN_STAGE(QN);
#pragma unroll 8
            for (int i = 0; i < 32; ++i) qmx = fmaxf(qmx, stg[33 * tid + i]);
            SCAN_STAGE(SD);
#pragma unroll 8
            for (int i = 0; i < 32; ++i) sdm = fminf(sdm, stg[33 * tid + i]);
            SCAN_STAGE(LFH);
#pragma unroll 8
            for (int i = 0; i < 32; ++i) loc += (double)stg[33 * tid + i];
#undef SCAN_STAGE
            sd[tid] = loc; __syncthreads();
            int cur = 0;
            for (int off = 1; off < 512; off <<= 1) { const double v = sd[cur * 512 + tid] + (tid >= off ? sd[cur * 512 + tid - off] : 0.0); sd[(cur ^ 1) * 512 + tid] = v; cur ^= 1; __syncthreads(); }
            double run = sd[cur * 512 + tid] - loc;
#pragma unroll 8
            for (int i = 0; i < 32; ++i) { run += (double)stg[33 * tid + i]; stg[33 * tid + i] = (float)(run * 11.313708498984761); }
            s_cend[tid] = (float)run; s_qmax[tid] = qmx; s_sdmin[tid] = sdm; s_kpre[tid] = kmx; __syncthreads();
            for (int k = 0; k < 32; ++k) { const int p = k * 512 + tid; bias_rows(stg[p + (p >> 5)], dk + (size_t)p * 8, dq + (size_t)p * 8); }
            if (tid < SEQ / 256) { const int qb = tid; int jlo = 0;
                if (qb > 0) { float q2 = 0.f, ml = 3.0e38f;
                    for (int i = 0; i < 8; ++i) { q2 = fmaxf(q2, s_qmax[8 * qb + i]); ml = fminf(ml, s_sdmin[8 * qb + i]); }
                    const float cq = s_cend[8 * qb - 1]; float S = 0.f;
                    for (int j = 0; j < 4 * qb; ++j) { const float U = 1.001f * 0.08838834764831845f * sqrtf(q2 * fmaxf(s_kpre[2 * j], s_kpre[2 * j + 1])) + (cq - s_cend[2 * j + 1]);
                        S += 64.64f * __expf(fminf(U - ml, 0.f));
                        if (S > PRUNE_EPS) break;
                        jlo = j + 1; } }
                JLO[s * (SEQ / 256) + qb] = jlo; }
        } else {
            const int s = task - NB * FH, b = s >> 4, h = s & 15; constexpr int L = PAST + DECT, per = 3;
            bf16* dk = (bf16*)(a->ws + WS_CKS) + (size_t)s * KCROWS * 8; bf16* dq = (bf16*)(a->ws + WS_CQS) + (size_t)s * KCROWS * 8;
            const int p0 = tid * per, p1 = (p0 + per < L) ? p0 + per : L;
            double loc = 0.0;
            for (int p = p0; p < p1; ++p) { const float v = p < PAST ? lc[((size_t)b * PAST + p) * FH + h] : lsm[((size_t)b * DECT + (p - PAST)) * FH + h]; loc += (double)v; }
            __syncthreads();
            sd[tid] = loc; __syncthreads();
            int cur = 0;
            for (int off = 1; off < 512; off <<= 1) { const double v = sd[cur * 512 + tid] + (tid >= off ? sd[cur * 512 + tid - off] : 0.0); sd[(cur ^ 1) * 512 + tid] = v; cur ^= 1; __syncthreads(); }
            double run = sd[cur * 512 + tid] - loc;
            for (int p = p0; p < p1; ++p) { const float v = p < PAST ? lc[((size_t)b * PAST + p) * FH + h] : lsm[((size_t)b * DECT + (p - PAST)) * FH + h]; run += (double)v;
                bias_rows((float)(run * 11.313708498984761), dk + (size_t)p * 8, dq + (size_t)p * 8); }
            const double tot = sd[cur * 512 + 511]; if (tid < KCROWS - (PAST + DECT)) bias_rows((float)(tot * 11.313708498984761), dk + (size_t)(PAST + DECT + tid) * 8, dq + (size_t)(PAST + DECT + tid) * 8);
        }
    }
    __syncthreads();
}

#ifndef MK_N_LAUNCHES
#define MK_N_LAUNCHES 1
#endif
constexpr int N_PHASES = 18;
constexpr bool ONE_LAUNCH = (MK_N_LAUNCHES == 1);

__global__ void __launch_bounds__(NWAVES * 64, 2) mk_fwd(Args args) {
    extern __shared__ __attribute__((aligned(16))) unsigned char lds[];
    LAS unsigned char* ldsl = (LAS unsigned char*)lds;
    volatile LAS unsigned* MISC = (volatile LAS unsigned*)(ldsl + MISC_OFF);
    gu32* ctl = (gu32*)(args.ws + WS_CTL);
    for (int u = fresh_tid(); u < (LDS_BYTES - LDSCTL_OFF) / 4; u += NWAVES * 64) ((LAS unsigned*)(ldsl + LDSCTL_OFF))[u] = 0u;
    __syncthreads();
    XcdBarrier bar; bar.bar = (unsigned*)(ctl + CW_BAR); bar.x = 0; bar.st = nullptr;
    if (ONE_LAUNCH) bar = xcd_barrier_post((unsigned*)(ctl + CW_BAR), MISC + 8);
#define GRID_BAR() do { if (ONE_LAUNCH) xcd_barrier(bar); } while (0)
    const int lo = args.ph_lo, hi = args.ph_hi;
#ifdef PHASE_MASK
#define IN(k) (((PHASE_MASK >> (k)) & 1) && lo <= (k) && (k) < hi)
#else
#define IN(k) (lo <= (k) && (k) < hi)
#endif
#define BOTH(k) (IN(k) && IN((k) + 1))
#define MKFRAME Frame F; { const int t_ = fresh_tid(); F.tid = t_; F.lane = t_ & 63; F.wave = __builtin_amdgcn_readfirstlane(t_ >> 6); F.G = gridDim.x; const int bx = blockIdx.x; F.vcu = (F.G % 8 == 0) ? (bx % 8) * (F.G / 8) + bx / 8 : bx; }
#define PHASE_PTRS MKFRAME; KA A = fresh_args(); unsigned char* ws = A->ws; float* out = A->out; float* X = out + O_Y; float* ADA = (float*)(ws + WS_ADA); const float* ADA1 = ADA + (size_t)NADA * ADAW; \
    bf16* Hb = (bf16*)(ws + WS_H); bf16* Qb = (bf16*)(ws + WS_Q); bf16* Kb = (bf16*)(ws + WS_K); bf16* Vb = (bf16*)(ws + WS_V); bf16* Ob = (bf16*)(ws + WS_O); bf16* Ab = (bf16*)(ws + WS_A); \
    float* RSS = (float*)(ws + WS_CTL + CTL_RSS); bf16* SH = (bf16*)(ws + WS_SH); (void)RSS; (void)SH; (void)X; (void)ADA; (void)ADA1; (void)Hb; (void)Qb; (void)Kb; (void)Vb; (void)Ob; (void)Ab; (void)out

    if (IN(0)) { MKFRAME; p0_prologue(fresh_args(), F, ldsl); if (BOTH(0)) GRID_BAR(); }
    if (IN(1)) { PHASE_PTRS; norm_rows(A->in[0], A->in[1], A->in[11], ADA, 0, Hb, F); fill_shift_rows(ADA, SH, F); if (BOTH(1)) GRID_BAR(); }
    if (IN(2)) { PHASE_PTRS;
        { const int c = (int)blockIdx.x;
          if ((F.G % 8 == 0) && (F.G / 8 > NWORK) && (c >> 3) < NWORK) { const int wgw = ((c & 7) * NWORK + (c >> 3)) * NWAVES + F.wave;
              p0_copies(A, ldsl, F.wave, F.lane, wgw, I_FIN, NITEMS, wgw, 8 * NWORK * NWAVES, true); __syncthreads(); } }
        pg8::Gemm g{Hb, (const bf16*)(ws + WS_WFIN), MP, 3 * DM, DM};
        pg8::DynOrder S; S.init(MP, 3 * DM, (int)blockIdx.x, (unsigned*)(ws + WS_CTL) + CW_DYN, (int)(uintptr_t)(LAS char*)(MISC + 16));
        pg8::EpiFoxIn E{Qb, (size_t)(WS_K - WS_Q) / 2, out};
        pg8::gemm_phase<pg8::EpiFoxIn, pg8::DynOrder, true, true, true, false>(ldsl + RING_OFF, g, S, E);
        { const sk::SkFoxIn Es{Qb, Kb, Vb, (bf16*)(ws + WS_KC), (bf16*)(ws + WS_VC), out};
          sk::sk_gemm<2, true, false, sk::SkFoxIn>(Hb, MP, MS / 64, (const bf16*)(ws + WS_WFIN), 0, 3 * DM / 64, DM, (char*)lds + RING_OFF, Es, F.vcu, F.G);
          const sk::SkGates Eg{out, A->in[14], (float*)(ws + WS_LFH)};
          sk::sk_gemm<1, true, false, sk::SkGates>(Hb, 0, MT / 64, (const bf16*)(ws + WS_WFIN), 3 * DM, 1, DM, (char*)lds + RING_OFF, Eg, F.vcu, F.G, 248); }
        if (BOTH(2)) GRID_BAR();
    }
    if (IN(3)) { PHASE_PTRS; fox_norms(Qb, Kb, (float*)(ws + WS_QN), (float*)(ws + WS_KN), (float*)(ws + WS_SD), F); if (BOTH(3)) GRID_BAR(); }
    if (IN(4)) { MKFRAME; fox_scan(fresh_args(), F, ldsl); if (BOTH(4)) GRID_BAR(); }
    if (IN(5)) { PHASE_PTRS;
        const fox::Tensors T{Qb, Kb, Vb, Ob, (const bf16*)(ws + WS_KC), (const bf16*)(ws + WS_VC), (const bf16*)(ws + WS_CKP), (const bf16*)(ws + WS_CQP), (const bf16*)(ws + WS_CKS), (const bf16*)(ws + WS_CQS), (const int*)(ws + WS_JLO)};
        fox::fox_phase((char*)lds + RING_OFF, T, F.vcu, F.G);
        if (BOTH(5)) GRID_BAR();
    }
    if (IN(6)) { PHASE_PTRS;
        pg8::Gemm g{Ob, (const bf16*)(ws + WS_WFOUT), MP, DM, DM}; pg8::StaticOrder S; S.init(MP, DM, F.G, (int)blockIdx.x);
        pg8::EpiResid<true> E{A->in[0], X, ADA + 2 * DM, A->in[12], ADA + 4 * DM, Hb, RSS};
        pg8::gemm_phase<pg8::EpiResid<true>, pg8::StaticOrder, true, true>(ldsl + RING_OFF, g, S, E);
        { const sk::SkResid<true> Es{A->in[1], X + (size_t)MP * DM, ADA + 2 * DM, A->in[12], ADA + 4 * DM, Hb, RSS};
          sk::sk_gemm<2, false, false, sk::SkResid<true>>(Ob, MP, MS / 64, (const bf16*)(ws + WS_WFOUT), 0, DM / 64, DM, (char*)lds + RING_OFF, Es, F.vcu, F.G); }
        { const sk::SkSW E0{(float*)(ws + WS_SW0), DFF}, E1{(float*)(ws + WS_SW1), SWA_IN}, E2{(float*)(ws + WS_SW2), DFF};
          sk::sk_gemm<2, false, false, sk::SkSW>(SH, 0, 1, (const bf16*)(ws + WS_WUP), 0, DFF / 64, DM, (char*)lds + RING_OFF, E0, F.vcu, F.G, 128);
          sk::sk_gemm<2, false, false, sk::SkSW>(SH + 64 * DM, 0, 1, (const bf16*)(ws + WS_WSIN), 0, SWA_IN / 64, DM, (char*)lds + RING_OFF, E1, F.vcu, F.G, 128);
          sk::sk_gemm<2, false, false, sk::SkSW>(SH + 2 * 64 * DM, 0, 1, (const bf16*)(ws + WS_WUP) + (size_t)DM * DFF, 0, DFF / 64, DM, (char*)lds + RING_OFF, E2, F.vcu, F.G); }
        if (BOTH(6)) GRID_BAR();
    }
    if (IN(8)) { PHASE_PTRS;
        pg8::Gemm g{Hb, (const bf16*)(ws + WS_WUP), MP, DFF, DM}; pg8::StaticOrder S; S.init(MP, DFF, F.G, (int)blockIdx.x);
        pg8::EpiUp E{Ab, RSS, (const float*)(ws + WS_SW0)};
        pg8::gemm_phase<pg8::EpiUp, pg8::StaticOrder, true, true, true, false>(ldsl + RING_OFF, g, S, E);
        { const sk::SkUp Es{Ab, RSS, (const float*)(ws + WS_SW0)}; sk::sk_gemm<2, true, false, sk::SkUp>(Hb, MP, MS / 64, (const bf16*)(ws + WS_WUP), 0, DFF / 64, DM, (char*)lds + RING_OFF, Es, F.vcu, F.G); }
        if (BOTH(8)) GRID_BAR();
    }
    if (IN(9)) { PHASE_PTRS;
        pg8::Gemm g{Ab, (const bf16*)(ws + WS_WDN), MP, DM, DFF}; pg8::StaticOrder S; S.init(MP, DM, F.G, (int)blockIdx.x);
        pg8::EpiResid<true> E{X, X, ADA + 5 * DM, A->in[11] + DM, ADA1 + 1 * DM, Hb, RSS + MT};
        pg8::gemm_phase<pg8::EpiResid<true>, pg8::StaticOrder, true, true>(ldsl + RING_OFF, g, S, E);
        { const sk::SkResid<true> Es{X + (size_t)MP * DM, X + (size_t)MP * DM, ADA + 5 * DM, A->in[11] + DM, ADA1 + 1 * DM, Hb, RSS + MT};
          sk::sk_gemm<2, false, false, sk::SkResid<true>>(Ab, MP, MS / 64, (const bf16*)(ws + WS_WDN), 0, DM / 64, DFF, (char*)lds + RING_OFF, Es, F.vcu, F.G); }
        if (BOTH(9)) GRID_BAR();
    }
    if (IN(11)) { PHASE_PTRS;
        pg8::Gemm g{Hb, (const bf16*)(ws + WS_WSIN), MP, SWA_IN, DM}; pg8::StaticOrder S; S.init(MP, SWA_IN, F.G, (int)blockIdx.x);
        pg8::EpiSwaIn E{Qb, Kb, Vb, out, (const float*)(ws + WS_ROPE), RSS + MT, (const float*)(ws + WS_SW1)};
        pg8::gemm_phase<pg8::EpiSwaIn, pg8::StaticOrder, true, true, true, false>(ldsl + RING_OFF, g, S, E);
        { const sk::SkSwaIn Es{Qb, Kb, Vb, (bf16*)(ws + WS_KSC), (bf16*)(ws + WS_VSC), out, (const float*)(ws + WS_ROPE), RSS + MT, (const float*)(ws + WS_SW1)};
          sk::sk_gemm<2, true, false, sk::SkSwaIn>(Hb, MP, MS / 64, (const bf16*)(ws + WS_WSIN), 0, SWA_IN / 64, DM, (char*)lds + RING_OFF, Es, F.vcu, F.G); }
        if (BOTH(11)) GRID_BAR();
    }
    if (IN(12)) { PHASE_PTRS;
        const swa::Tensors T{Qb, Kb, Vb, Ob, (const bf16*)(ws + WS_KSC), (const bf16*)(ws + WS_VSC), A->in[17]};
        swa::swa_phase((char*)lds + RING_OFF, T, F.vcu, F.G);
        if (BOTH(12)) GRID_BAR();
    }
    if (IN(13)) { PHASE_PTRS;
        pg8::Gemm g{Ob, (const bf16*)(ws + WS_WSOUT), MP, DM, DM}; pg8::StaticOrder S; S.init(MP, DM, F.G, (int)blockIdx.x);
        pg8::EpiResid<true> E{X, X, ADA1 + 2 * DM, A->in[12] + DM, ADA1 + 4 * DM, Hb, RSS + 2 * MT};
        pg8::gemm_phase<pg8::EpiResid<true>, pg8::StaticOrder, true, true>(ldsl + RING_OFF, g, S, E);
        { const sk::SkResid<true> Es{X + (size_t)MP * DM, X + (size_t)MP * DM, ADA1 + 2 * DM, A->in[12] + DM, ADA1 + 4 * DM, Hb, RSS + 2 * MT};
          sk::sk_gemm<2, false, false, sk::SkResid<true>>(Ob, MP, MS / 64, (const bf16*)(ws + WS_WSOUT), 0, DM / 64, DM, (char*)lds + RING_OFF, Es, F.vcu, F.G); }
        if (BOTH(13)) GRID_BAR();
    }
    if (IN(15)) { PHASE_PTRS;
        pg8::Gemm g{Hb, (const bf16*)(ws + WS_WUP) + (size_t)DM * DFF, MP, DFF, DM}; pg8::StaticOrder S; S.init(MP, DFF, F.G, (int)blockIdx.x);
        pg8::EpiUp E{Ab, RSS + 2 * MT, (const float*)(ws + WS_SW2)};
        pg8::gemm_phase<pg8::EpiUp, pg8::StaticOrder, true, true, true, false>(ldsl + RING_OFF, g, S, E);
        { const sk::SkUp Es{Ab, RSS + 2 * MT, (const float*)(ws + WS_SW2)}; sk::sk_gemm<2, true, false, sk::SkUp>(Hb, MP, MS / 64, (const bf16*)(ws + WS_WUP) + (size_t)DM * DFF, 0, DFF / 64, DM, (char*)lds + RING_OFF, Es, F.vcu, F.G); }
        if (BOTH(15)) GRID_BAR();
    }
    if (IN(16)) { PHASE_PTRS;
        pg8::Gemm g{Ab, (const bf16*)(ws + WS_WDN) + (size_t)DM * DFF, MP, DM, DFF}; pg8::StaticOrder S; S.init(MP, DM, F.G, (int)blockIdx.x);
        pg8::EpiResid<false> E{X, X, ADA1 + 5 * DM, nullptr, nullptr, nullptr, nullptr};
        pg8::gemm_phase<pg8::EpiResid<false>, pg8::StaticOrder, true, true>(ldsl + RING_OFF, g, S, E);
        { const sk::SkResid<false> Es{X + (size_t)MP * DM, X + (size_t)MP * DM, ADA1 + 5 * DM, nullptr, nullptr, nullptr, nullptr};
          sk::sk_gemm<2, false, false, sk::SkResid<false>>(Ab, MP, MS / 64, (const bf16*)(ws + WS_WDN) + (size_t)DM * DFF, 0, DM / 64, DFF, (char*)lds + RING_OFF, Es, F.vcu, F.G); }
        if (BOTH(16)) GRID_BAR();
    }
    if (IN(17)) { PHASE_PTRS; final_norm(X, A->in[21], F); }
#undef PHASE_PTRS
#undef MKFRAME
#undef IN
#undef BOTH
#undef GRID_BAR
}

extern "C" void kernel_launch(void* const* d_in, const int* in_sizes, int n_in, void* d_out, int out_size, void* d_ws, size_t ws_size, hipStream_t stream) {
    static int grid = 0;
    if (grid == 0) {
        if (n_in != 22 || (size_t)out_size != O_END || ws_size < WS_END) { fprintf(stderr, "kernel_launch: shape mismatch n_in %d out %d (want %zu) ws %zu (want %zu)\n", n_in, out_size, (size_t)O_END, ws_size, (size_t)WS_END); grid = -1; return; }
        int dev = 0, cus = 0, per_cu = 0;
        if (hipGetDevice(&dev) != hipSuccess || hipDeviceGetAttribute(&cus, hipDeviceAttributeMultiprocessorCount, dev) != hipSuccess) { grid = -1; return; }
        if (hipFuncSetAttribute((const void*)mk_fwd, hipFuncAttributeMaxDynamicSharedMemorySize, LDS_BYTES) != hipSuccess) { fprintf(stderr, "kernel_launch: hipFuncSetAttribute failed\n"); grid = -1; return; }
        if (hipOccupancyMaxActiveBlocksPerMultiprocessor(&per_cu, (const void*)mk_fwd, NWAVES * 64, LDS_BYTES) != hipSuccess || per_cu < 1) { fprintf(stderr, "kernel_launch: occupancy query says %d\n", per_cu); }
        (void)hipGetLastError();
        grid = cus;
    }
    if (grid < 0) return;
    (void)hipMemsetAsync((char*)d_ws + WS_CTL, 0, CTL_ZERO_BYTES, stream);
    Args a{};
    for (int i = 0; i < 22; ++i) a.in[i] = (const float*)d_in[i];
    a.out = (float*)d_out; a.ws = (unsigned char*)d_ws;
    if (ONE_LAUNCH) { a.ph_lo = 0; a.ph_hi = N_PHASES; a.li = 0; hipLaunchKernelGGL(mk_fwd, dim3(grid), dim3(NWAVES * 64), LDS_BYTES, stream, a); }
    else { for (int p = 0; p < N_PHASES; ++p) { a.ph_lo = p; a.ph_hi = p + 1; a.li = p; hipLaunchKernelGGL(mk_fwd, dim3(grid), dim3(NWAVES * 64), LDS_BYTES, stream, a); } }
}
```
